# Optimizing an MI355X kernel written in HIP

```python
import jax, jax.numpy as jnp
from jax import lax
import numpy as np

D_MODEL = 1024
BATCH = 4
SEQ = 4096
DEPTH = 2

GRID_W = 64
CTX_LEN = 256
N_MOD = 6
EPS = 1e-6

HEAD_DIM = 64
N_Q_HEADS = 8
N_KV_HEADS = 2
Q_PER_KV = N_Q_HEADS // N_KV_HEADS
ATT_W = N_Q_HEADS * HEAD_DIM
KV_W = N_KV_HEADS * HEAD_DIM
WINDOW = 128
ATT_BLOCK = 128
ROPE_PAIRS = HEAD_DIM // 4
ROPE_BASE = 10000.0

SC_W = D_MODEL // 2
SC_WIDTH = 3
SC_PAD = (SC_WIDTH // 2, SC_WIDTH - 1 - SC_WIDTH // 2)
IN_AB = 2 * KV_W + ATT_W + 3 * SC_W
AB_SPLITS = [KV_W, 2 * KV_W, 2 * KV_W + ATT_W, 2 * KV_W + ATT_W + SC_W, 2 * KV_W + ATT_W + 2 * SC_W]

POOL_W = D_MODEL // 2
POOL_WINDOWS = (2, 4, 8, 16)
POOL_GROUPS = len(POOL_WINDOWS)
POOL_GW = POOL_W // POOL_GROUPS

LRU_W = D_MODEL // 2
LRU_BLOCKS = 8
LRU_BW = LRU_W // LRU_BLOCKS
LRU_CONV = 4
LRU_PAD = (LRU_CONV // 2, LRU_CONV - 1 - LRU_CONV // 2)
LRU_C = 8.0
IN_CD = 2 * LRU_W + POOL_W
CD_SPLITS = [LRU_W, 2 * LRU_W]

MIX_W = D_MODEL

N_GROUPS = 4
EXPERTS_PER_GROUP = 8
N_EXPERTS = N_GROUPS * EXPERTS_PER_GROUP
TOP_K = 2
D_EXPERT = D_MODEL // 2
MOE_BLOCK = 128

kernel_name = "hybrid_diffusion_prefix_backbone"


def rmsnorm(x, g):
    xf = x.astype(jnp.float32)
    y = xf * lax.rsqrt(jnp.mean(xf * xf, axis=-1, keepdims=True) + EPS)
    return (y * g.astype(jnp.float32)).astype(x.dtype)


def modulate(x, g, shift, scale):
    return rmsnorm(x, g) * (1 + scale) + shift


def depthwise_conv(u, w, b, pad):
    y = lax.conv_general_dilated(u, w[:, None, :], window_strides=(1,), padding=[pad],
                                 dimension_numbers=("NWC", "WIO", "NWC"),
                                 feature_group_count=u.shape[-1])
    return y + b


def axial_rope_tables(n_tokens):
    rows = n_tokens // GRID_W
    row = jnp.repeat(jnp.arange(rows), GRID_W)
    col = jnp.tile(jnp.arange(GRID_W), rows)
    inv_freq = ROPE_BASE ** (-jnp.arange(ROPE_PAIRS, dtype=jnp.float32) / ROPE_PAIRS)
    ang = jnp.stack([row, col], axis=-1).astype(jnp.float32)[..., None] * inv_freq
    return jnp.cos(ang), jnp.sin(ang)


def apply_rope(x, cos, sin):
    shp = x.shape
    bshape = (1, shp[1]) + (1,) * (x.ndim - 3) + cos.shape[1:]
    cos, sin = cos.reshape(bshape), sin.reshape(bshape)
    xr = x.astype(jnp.float32).reshape(shp[:-1] + (2, 2, ROPE_PAIRS))
    x1, x2 = xr[..., 0, :], xr[..., 1, :]
    out = jnp.stack([x1 * cos - x2 * sin, x2 * cos + x1 * sin], axis=-2)
    return out.reshape(shp).astype(x.dtype)


def window_attention(q, k, v, kc, vc, sink):
    Bn, L = q.shape[:2]
    nb = L // ATT_BLOCK
    qb = q.reshape(Bn, nb, ATT_BLOCK, N_KV_HEADS, Q_PER_KV, HEAD_DIM)

    def band(t):
        tp = jnp.pad(t, ((0, 0), (ATT_BLOCK, ATT_BLOCK), (0, 0), (0, 0)))
        tp = tp.reshape(Bn, nb + 2, ATT_BLOCK, N_KV_HEADS, HEAD_DIM)
        return jnp.concatenate([tp[:, :-2], tp[:, 1:-1], tp[:, 2:]], axis=2)

    kb, vb = band(k), band(v)
    scale = HEAD_DIM ** -0.5
    s_loc = jnp.einsum("bnqhgd,bnkhd->bnhgqk", qb, kb).astype(jnp.float32) * scale
    s_ctx = jnp.einsum("bnqhgd,bchd->bnhgqc", qb, kc).astype(jnp.float32) * scale
    i = jnp.arange(ATT_BLOCK)[:, None]
    j = jnp.arange(3 * ATT_BLOCK)[None, :]
    kpos = (jnp.arange(nb)[:, None, None] - 1) * ATT_BLOCK + j
    valid = (jnp.abs(i - j + ATT_BLOCK) <= WINDOW) & (kpos >= 0) & (kpos < L)
    s_loc = jnp.where(valid[None, :, None, None], s_loc, -jnp.inf)
    snk = jnp.broadcast_to(sink.astype(jnp.float32).reshape(1, 1, N_KV_HEADS, Q_PER_KV, 1, 1),
                           s_loc.shape[:-1] + (1,))
    p = jax.nn.softmax(jnp.concatenate([s_loc, s_ctx, snk], axis=-1), axis=-1).astype(v.dtype)
    n_loc, n_ctx = 3 * ATT_BLOCK, kc.shape[1]
    o = (jnp.einsum("bnhgqk,bnkhd->bnqhgd", p[..., :n_loc], vb)
         + jnp.einsum("bnhgqc,bchd->bnqhgd", p[..., n_loc:n_loc + n_ctx], vc))
    return o.reshape(Bn, L, ATT_W)


def context_attention(qc, kc, vc, sink):
    Bn, Lc = qc.shape[:2]
    s = jnp.einsum("bqhgd,bkhd->bhgqk", qc, kc).astype(jnp.float32) * HEAD_DIM ** -0.5
    snk = jnp.broadcast_to(sink.astype(jnp.float32).reshape(1, N_KV_HEADS, Q_PER_KV, 1, 1),
                           s.shape[:-1] + (1,))
    p = jax.nn.softmax(jnp.concatenate([s, snk], axis=-1), axis=-1).astype(vc.dtype)
    o = jnp.einsum("bhgqk,bkhd->bqhgd", p[..., :-1], vc)
    return o.reshape(Bn, Lc, ATT_W)


def multiscale_pool(u, w_pool, scale):
    Bn, L, _ = u.shape
    uf = u.astype(jnp.float32)
    cs = jnp.pad(lax.cumsum(uf, axis=1), ((0, 0), (1, 0), (0, 0)))
    t = jnp.arange(L)
    means = []
    for g, w in enumerate(POOL_WINDOWS):
        lo = jnp.clip(t - w // 2, 0, L)
        hi = jnp.clip(t + w - w // 2, 0, L)
        csg = cs[..., g * POOL_GW:(g + 1) * POOL_GW]
        means.append((csg[:, hi] - csg[:, lo]) / (hi - lo).astype(jnp.float32)[None, :, None])
    d = (jnp.concatenate(means, axis=-1) - uf).astype(u.dtype)
    d = d.reshape(Bn, L, POOL_GROUPS, POOL_GW)
    y = jnp.einsum("blgi,gij->blgj", d, w_pool).reshape(Bn, L, POOL_W)
    return y * scale


def rglru_coeffs(u, wa, ba, wx, bx, lam):
    ub = u.reshape(u.shape[:-1] + (LRU_BLOCKS, LRU_BW))
    r = jax.nn.sigmoid((jnp.einsum("blhi,hij->blhj", ub, wa).reshape(u.shape) + ba).astype(jnp.float32))
    gi = jax.nn.sigmoid((jnp.einsum("blhi,hij->blhj", ub, wx).reshape(u.shape) + bx).astype(jnp.float32))
    log_a = -LRU_C * jax.nn.softplus(-lam.astype(jnp.float32)) * r
    a = jnp.exp(log_a)
    b = jnp.sqrt(-jnp.expm1(2 * log_a)) * gi * u.astype(jnp.float32)
    return a, b


def linear_scan(a, b, h0, reverse):
    idx = -1 if reverse else 0
    b = b.at[:, idx].add(a[:, idx] * h0)

    def combine(l, r):
        return l[0] * r[0], r[0] * l[1] + r[1]

    _, h = lax.associative_scan(combine, (a, b), axis=1, reverse=reverse)
    return h


def merge_branches(branches, g_out, w_out):
    splits = list(np.cumsum([br.shape[-1] for br in branches])[:-1])
    gains = jnp.split(g_out, splits)
    y = jnp.concatenate([rmsnorm(br, g) for br, g in zip(branches, gains)], axis=-1)
    return y @ w_out


def expert_dispatch(h, e_idx, w, w1, w3, w2):
    T, D = h.shape
    n = T * TOP_K
    flat_e = e_idx.reshape(-1)
    order = jnp.argsort(flat_e)
    sorted_e = flat_e[order]
    counts = jnp.bincount(flat_e, length=N_EXPERTS)
    padded = (counts + MOE_BLOCK - 1) // MOE_BLOCK * MOE_BLOCK
    pad_end = jnp.cumsum(padded)
    pad_start = pad_end - padded
    seg_start = jnp.cumsum(counts) - counts
    dest_sorted = pad_start[sorted_e] + jnp.arange(n) - seg_start[sorted_e]
    dest = jnp.zeros((n,), jnp.int32).at[order].set(dest_sorted.astype(jnp.int32))
    n_blocks = (n + N_EXPERTS * (MOE_BLOCK - 1) + MOE_BLOCK - 1) // MOE_BLOCK
    n_slots = n_blocks * MOE_BLOCK
    slot_tok = jnp.full((n_slots,), T, jnp.int32).at[dest].set(jnp.arange(n, dtype=jnp.int32) // TOP_K)
    block_e = jnp.minimum(jnp.searchsorted(pad_end, jnp.arange(n_blocks) * MOE_BLOCK, side="right"),
                          N_EXPERTS - 1)
    xs = jnp.concatenate([h, jnp.zeros((1, D), h.dtype)], axis=0)[slot_tok]
    xs = xs.reshape(n_blocks, MOE_BLOCK, D)

    def run_block(args):
        xb, e = args
        return (jax.nn.silu(xb @ w1[e]) * (xb @ w3[e])) @ w2[e]

    ys = lax.map(run_block, (xs, block_e)).reshape(n_slots, D)
    return jnp.einsum("tkd,tk->td", ys[dest].reshape(T, TOP_K, D), w)


def hier_moe(h, gw, gb, ew, eb, w1, w3, w2):
    T = h.shape[0]
    hf = h.astype(jnp.float32)
    p_group = jax.nn.softmax(hf @ gw.astype(jnp.float32) + gb.astype(jnp.float32), axis=-1)
    p_sel, g_idx = lax.top_k(p_group, 1)
    e_logits = (hf @ ew.astype(jnp.float32) + eb.astype(jnp.float32)).reshape(T, N_GROUPS, EXPERTS_PER_GROUP)
    e_logits = jnp.take_along_axis(e_logits, g_idx[:, :, None], axis=1)[:, 0]
    p_top, e_local = lax.top_k(jax.nn.softmax(e_logits, axis=-1), TOP_K)
    w = p_sel * p_top / jnp.sum(p_top, axis=-1, keepdims=True)
    e_idx = g_idx * EXPERTS_PER_GROUP + e_local
    return expert_dispatch(h, e_idx, w.astype(h.dtype), w1, w3, w2)


def even_mixer(h, hc, w_in, q_g, k_g, sink, cw, cb, cos, sin, need_ctx):
    z = h @ w_in
    k, v, q, gb, gc, gx = jnp.split(z, AB_SPLITS, axis=-1)
    zc = hc @ (w_in if need_ctx else w_in[:, :2 * KV_W])
    kc, vc = zc[..., :KV_W], zc[..., KV_W:2 * KV_W]

    def kv_heads(t):
        return t.reshape(t.shape[:-1] + (N_KV_HEADS, HEAD_DIM))

    def q_heads(t):
        return t.reshape(t.shape[:-1] + (N_KV_HEADS, Q_PER_KV, HEAD_DIM))

    q = apply_rope(rmsnorm(q_heads(q), q_g), cos, sin)
    k = apply_rope(rmsnorm(kv_heads(k), k_g), cos, sin)
    kc = rmsnorm(kv_heads(kc), k_g)
    vc = kv_heads(vc)
    att = window_attention(q, k, kv_heads(v), kc, vc, sink)
    conv = gb * depthwise_conv(gc * gx, cw, cb, SC_PAD)
    if not need_ctx:
        return [att, conv], None
    _, _, qc, gbc, gcc, gxc = jnp.split(zc, AB_SPLITS, axis=-1)
    att_c = context_attention(rmsnorm(q_heads(qc), q_g), kc, vc, sink)
    conv_c = gbc * depthwise_conv(gcc * gxc, cw, cb, SC_PAD)
    return [att, conv], [att_c, conv_c]


def odd_mixer(h, hc, w_in, pool_w, pool_scale, conv_w, conv_b, wa, ba, wx, bx, lam, need_ctx):
    z = h @ w_in
    ux, ug, up = jnp.split(z, CD_SPLITS, axis=-1)
    zc = hc @ (w_in if need_ctx else w_in[:, :LRU_W])
    xl = depthwise_conv(ux, conv_w, conv_b, LRU_PAD)
    xc = depthwise_conv(zc[..., :LRU_W], conv_w, conv_b, LRU_PAD)
    h_lat = jnp.zeros(xl.shape, jnp.float32)
    ctx_states = []
    for d, reverse in enumerate((False, True)):
        a_c, b_c = rglru_coeffs(xc, wa[d], ba[d], wx[d], bx[d], lam[d])
        hs_c = linear_scan(a_c, b_c, jnp.zeros_like(b_c[:, 0]), reverse)
        h0 = hs_c[:, 0] if reverse else hs_c[:, -1]
        a_l, b_l = rglru_coeffs(xl, wa[d], ba[d], wx[d], bx[d], lam[d])
        h_lat = h_lat + linear_scan(a_l, b_l, h0, reverse)
        ctx_states.append(hs_c)
    lat = [multiscale_pool(up, pool_w, pool_scale), h_lat.astype(ug.dtype) * jax.nn.gelu(ug)]
    if not need_ctx:
        return lat, None
    _, ugc, upc = jnp.split(zc, CD_SPLITS, axis=-1)
    h_ctx = (ctx_states[0] + ctx_states[1]).astype(ugc.dtype)
    return lat, [multiscale_pool(upc, pool_w, pool_scale), h_ctx * jax.nn.gelu(ugc)]


def setup_inputs(seed: int = 0) -> dict:
    key = jax.random.key(seed)
    ks = iter(jax.random.split(key, 48))
    n_even, n_odd = (DEPTH + 1) // 2, DEPTH // 2

    def nrm(shape, std):
        return std * jax.random.normal(next(ks), shape, jnp.float32)

    def gain(shape):
        return 1.0 + 0.05 * jax.random.normal(next(ks), shape, jnp.float32)

    u = jax.random.uniform(next(ks), (n_odd, 2, LRU_W), jnp.float32, 0.9, 0.999)
    a0 = u ** (1.0 / LRU_C)
    lru_lambda = jnp.log(a0) - jnp.log1p(-a0)
    return {
        "x": nrm((BATCH, SEQ, D_MODEL), 1.0),
        "c": nrm((BATCH, D_MODEL), 1.0),
        "ctx": nrm((BATCH, CTX_LEN, D_MODEL), 1.0),
        "c_ctx": nrm((D_MODEL,), 1.0),
        "ada_w": nrm((DEPTH, D_MODEL, N_MOD * D_MODEL), 0.5 * D_MODEL ** -0.5),
        "ada_b": nrm((DEPTH, N_MOD * D_MODEL), 0.02),
        "norm_mix": gain((DEPTH, D_MODEL)),
        "norm_ffn": gain((DEPTH, D_MODEL)),
        "out_norm": gain((DEPTH, MIX_W)),
        "w_out": nrm((DEPTH, MIX_W, D_MODEL), MIX_W ** -0.5),
        "w_in_ab": nrm((n_even, D_MODEL, IN_AB), D_MODEL ** -0.5),
        "q_norm": gain((n_even, HEAD_DIM)),
        "k_norm": gain((n_even, HEAD_DIM)),
        "attn_sink": nrm((n_even, N_Q_HEADS), 0.5),
        "sconv_w": nrm((n_even, SC_WIDTH, SC_W), SC_WIDTH ** -0.5),
        "sconv_b": nrm((n_even, SC_W), 0.02),
        "w_in_cd": nrm((n_odd, D_MODEL, IN_CD), D_MODEL ** -0.5),
        "pool_w": nrm((n_odd, POOL_GROUPS, POOL_GW, POOL_GW), POOL_GW ** -0.5),
        "pool_scale": gain((n_odd, POOL_W)),
        "lru_conv_w": nrm((n_odd, LRU_CONV, LRU_W), LRU_CONV ** -0.5),
        "lru_conv_b": nrm((n_odd, LRU_W), 0.02),
        "lru_wa": nrm((n_odd, 2, LRU_BLOCKS, LRU_BW, LRU_BW), LRU_BW ** -0.5),
        "lru_ba": nrm((n_odd, 2, LRU_W), 0.02),
        "lru_wx": nrm((n_odd, 2, LRU_BLOCKS, LRU_BW, LRU_BW), LRU_BW ** -0.5),
        "lru_bx": nrm((n_odd, 2, LRU_W), 0.02),
        "lru_lambda": lru_lambda,
        "router_gw": nrm((DEPTH, D_MODEL, N_GROUPS), D_MODEL ** -0.5),
        "router_gb": nrm((DEPTH, N_GROUPS), 0.01),
        "router_ew": nrm((DEPTH, D_MODEL, N_EXPERTS), D_MODEL ** -0.5),
        "router_eb": nrm((DEPTH, N_EXPERTS), 0.01),
        "exp_w1": nrm((DEPTH, N_EXPERTS, D_MODEL, D_EXPERT), D_MODEL ** -0.5),
        "exp_w3": nrm((DEPTH, N_EXPERTS, D_MODEL, D_EXPERT), D_MODEL ** -0.5),
        "exp_w2": nrm((DEPTH, N_EXPERTS, D_EXPERT, D_MODEL), D_EXPERT ** -0.5),
    }


def reference(x, c, ctx, c_ctx, ada_w, ada_b, norm_mix, norm_ffn, out_norm, w_out,
              w_in_ab, q_norm, k_norm, attn_sink, sconv_w, sconv_b,
              w_in_cd, pool_w, pool_scale, lru_conv_w, lru_conv_b, lru_wa, lru_ba, lru_wx, lru_bx, lru_lambda,
              router_gw, router_gb, router_ew, router_eb, exp_w1, exp_w3, exp_w2):
    Bn, L, D = x.shape
    cos, sin = axial_rope_tables(L)
    for i in range(DEPTH):
        need_ctx = i < DEPTH - 1
        j = i // 2
        mod = jnp.split((jax.nn.silu(c) @ ada_w[i] + ada_b[i])[:, None, :], N_MOD, axis=-1)
        mod_c = jnp.split(jax.nn.silu(c_ctx) @ ada_w[i] + ada_b[i], N_MOD, axis=-1)
        h = modulate(x, norm_mix[i], mod[0], mod[1])
        hc = modulate(ctx, norm_mix[i], mod_c[0], mod_c[1])
        if i % 2 == 0:
            lat, cx = even_mixer(h, hc, w_in_ab[j], q_norm[j], k_norm[j], attn_sink[j],
                                 sconv_w[j], sconv_b[j], cos, sin, need_ctx)
        else:
            lat, cx = odd_mixer(h, hc, w_in_cd[j], pool_w[j], pool_scale[j], lru_conv_w[j], lru_conv_b[j],
                                lru_wa[j], lru_ba[j], lru_wx[j], lru_bx[j], lru_lambda[j], need_ctx)
        x = x + mod[2] * merge_branches(lat, out_norm[i], w_out[i])
        tokens = modulate(x, norm_ffn[i], mod[3], mod[4]).reshape(-1, D)
        if need_ctx:
            ctx = ctx + mod_c[2] * merge_branches(cx, out_norm[i], w_out[i])
            hc = modulate(ctx, norm_ffn[i], mod_c[3], mod_c[4])
            tokens = jnp.concatenate([tokens, hc.reshape(-1, D)], axis=0)
        y = hier_moe(tokens, router_gw[i], router_gb[i], router_ew[i], router_eb[i],
                     exp_w1[i], exp_w3[i], exp_w2[i])
        x = x + mod[5] * y[:Bn * L].reshape(Bn, L, D)
        if need_ctx:
            ctx = ctx + mod_c[5] * y[Bn * L:].reshape(ctx.shape)
    return x
```

```cpp
#include <hip/hip_runtime.h>
#include <cstdio>
#include <cstdint>

#define LAS __attribute__((address_space(3)))
#define GAS __attribute__((address_space(1)))
typedef unsigned short bf16_t;
typedef short bf16x8 __attribute__((ext_vector_type(8)));
typedef float f32x4 __attribute__((ext_vector_type(4)));
typedef float f32x2 __attribute__((ext_vector_type(2)));
typedef unsigned u32x4 __attribute__((ext_vector_type(4)));
typedef unsigned u32x2 __attribute__((ext_vector_type(2)));

#ifndef MK_PER_PHASE
#define MK_PER_PHASE 0
#endif

constexpr int DM = 1024, SEQL = 4096, NT = 16384, CTXL = 256, NCX = 1024, NR = 17408;
constexpr int IN_AB = 2304, IN_CD = 1536, NEXP = 32, DEXP = 512;
constexpr float EPSF = 1e-6f;
constexpr int MAX_MT = 168, NSLOT = MAX_MT * 256;
constexpr int NWAVES = 8, NTHR = 512;

constexpr size_t MiB = 1u << 20;
constexpr size_t WS_CTL = 0, CTL_ZERO_BYTES = 1 * MiB;
constexpr size_t WS_MODS = 1 * MiB, WS_EIDX = 2 * MiB, WS_EWT = 3 * MiB, WS_TOKSLOT = 4 * MiB, WS_SLOTTOK = 5 * MiB;
constexpr size_t WS_WAB = 6 * MiB, WS_WOUT = 11 * MiB, WS_WCD = 15 * MiB, WS_W13 = 18 * MiB, WS_W2 = 82 * MiB;
constexpr size_t WS_HBUF = 114 * MiB, WS_Z = 149 * MiB, WS_YBUF = 226 * MiB, WS_XBUF = 260 * MiB, WS_H = 328 * MiB, WS_S = 370 * MiB, WS_END = 438 * MiB;
constexpr size_t WS_Y = WS_Z;
constexpr size_t WS_HLAT = WS_H;
constexpr int CW_BAR = 4096, CW_CNT = 8192, CW_CUR = 8192 + 128;

constexpr int RING_BYTES = 131072, LDSCTL_OFF = RING_BYTES, LDS_MOE_OFF = LDSCTL_OFF + 512, LDS_BYTES = 147456;

namespace pg8 {
constexpr int BM = 256, BK = 64, HALF = 128, HTB = HALF * BK * 2, NXCD = 8, WGM = 8;
__host__ __device__ __forceinline__ int lds_byte(int r, int c) { const int st = (r >> 4) * 2 + (c >> 5), rr = r & 15, cc = c & 31, ob = rr * 64 + cc * 2; return st * 1024 + (ob ^ (((ob >> 9) & 1) << 5)); }
__host__ __device__ __forceinline__ void stage_rc(int b, int& R, int& C) { const int st = b / 1024, sb = b % 1024, swz = sb ^ (((sb >> 9) & 1) << 5); R = (st >> 1) * 16 + swz / 64; C = (st & 1) * 32 + (swz % 64) / 2; }
__host__ __device__ __forceinline__ int perm32(int rho) { const int n = rho >> 4, i = rho & 15; return 8 * (i >> 2) + 4 * n + (i & 3); }
struct Unit { int pm, pn, e; };

struct DenseOrder {
    const char* A; const char* Bt; int K, nM, nN, nwg, G, c;
    __device__ void init(const void* A_, const void* Bt_, int M, int N, int K_, int G_, int c_) { A = (const char*)A_; Bt = (const char*)Bt_; K = K_; nM = M / BM; nN = N / BM; nwg = nM * nN; G = G_; c = c_; }
    __device__ bool next(int i, Unit& u) const {
        const long L = (long)i * G + c; if (L >= nwg) return false;
        int wgid = (int)L; { const int q = nwg / NXCD, r = nwg % NXCD, xcd = wgid % NXCD, off = wgid / NXCD; wgid = (xcd < r ? xcd * (q + 1) : r * (q + 1) + (xcd - r) * q) + off; }
        const int nig = WGM * nN, gid = wgid / nig, fm = gid * WGM, gsz = (nM - fm) < WGM ? (nM - fm) : WGM;
        u.pm = fm + ((wgid % nig) % gsz); u.pn = (wgid % nig) / gsz; u.e = 0; return true;
    }
    __device__ __forceinline__ const char* a_base(const Unit& u) const { return A + (size_t)u.pm * BM * K * 2; }
    __device__ __forceinline__ const char* b_base(const Unit& u) const { return Bt + (size_t)u.pn * BM * K * 2; }
    __device__ __forceinline__ int gather_row(const Unit&, int) const { return 0; }
};
struct MoeOrder {
    const char* A; const char* Bt; int K; size_t estride; int nN, G, c, n_mt; const LAS int* tile_e; const int* slot_tok;
    __device__ bool next(int i, Unit& u) const { const long L = (long)i * G + c; if (L >= (long)n_mt * nN) return false; u.pm = (int)(L / nN); u.pn = (int)(L % nN); u.e = tile_e[u.pm]; return true; }
    __device__ __forceinline__ const char* a_base(const Unit& u) const { return slot_tok ? A : A + (size_t)u.pm * BM * K * 2; }
    __device__ __forceinline__ const char* b_base(const Unit& u) const { return Bt + (size_t)u.e * estride + (size_t)u.pn * BM * K * 2; }
    __device__ __forceinline__ int gather_row(const Unit& u, int r) const { return slot_tok[u.pm * BM + r]; }
};

__device__ __forceinline__ unsigned cvt_pk_bf16(float lo, float hi) { unsigned r; asm volatile("v_cvt_pk_bf16_f32 %0, %1, %2" : "=v"(r) : "v"(lo), "v"(hi)); return r; }

struct EpiBf16 {
    static constexpr bool PERM = true;
    bf16_t* O; int ldc;
    __device__ __forceinline__ void operator()(const f32x4 (&acc)[2][2][4][2], const Unit& u, int wr, int wc, int fr, int fq) const {
        const int row0 = u.pm * BM + wr * 64 + fr, col0 = u.pn * BM + wc * 32 + 8 * fq;
#pragma unroll
        for (int ai = 0; ai < 2; ++ai)
#pragma unroll
            for (int m = 0; m < 4; ++m) { bf16_t* rowp = O + (size_t)(row0 + ai * HALF + m * 16) * ldc + col0;
#pragma unroll
                for (int bj = 0; bj < 2; ++bj) { const f32x4 v0 = acc[ai][bj][m][0], v1 = acc[ai][bj][m][1];
                    u32x4 w; w.x = cvt_pk_bf16(v0[0], v0[1]); w.y = cvt_pk_bf16(v0[2], v0[3]); w.z = cvt_pk_bf16(v1[0], v1[1]); w.w = cvt_pk_bf16(v1[2], v1[3]);
                    *(u32x4*)(rowp + bj * HALF) = w; } }
    }
};
struct EpiX {
    static constexpr bool PERM = false;
    const float* res_lat; const float* res_ctx; const float* gate; float* out;
    __device__ __forceinline__ void operator()(const f32x4 (&acc)[2][2][4][2], const Unit& u, int wr, int wc, int fr, int fq) const {
        const int row0 = u.pm * BM + wr * 64 + fr, col0 = u.pn * BM + wc * 32 + 4 * fq;
#pragma unroll
        for (int ai = 0; ai < 2; ++ai)
#pragma unroll
            for (int m = 0; m < 4; ++m) {
                const int row = row0 + ai * HALF + m * 16;
                const float* rp = row < NT ? res_lat + (size_t)row * DM : res_ctx + (size_t)(row - NT) * DM;
                const float* gp = gate + (size_t)(row < NT ? (row >> 12) : 4) * 6144;
                float* op = out + (size_t)row * DM;
#pragma unroll
                for (int bj = 0; bj < 2; ++bj)
#pragma unroll
                    for (int n = 0; n < 2; ++n) { const int col = col0 + bj * HALF + n * 16;
                        const f32x4 r = *(const f32x4*)(rp + col), g = *(const f32x4*)(gp + col);
                        *(f32x4*)(op + col) = r + g * acc[ai][bj][m][n]; }
            }
    }
};
__device__ __forceinline__ float silu_fast(float x) { return x * __builtin_amdgcn_rcpf(1.0f + __builtin_amdgcn_exp2f(-1.44269504f * x)); }
struct EpiH {
    static constexpr bool PERM = true;
    bf16_t* H;
    __device__ __forceinline__ void operator()(const f32x4 (&acc)[2][2][4][2], const Unit& u, int wr, int wc, int fr, int fq) const {
        const int row0 = u.pm * BM + wr * 64 + fr, col0 = u.pn * HALF + wc * 32 + 8 * fq;
#pragma unroll
        for (int ai = 0; ai < 2; ++ai)
#pragma unroll
            for (int m = 0; m < 4; ++m) { bf16_t* rowp = H + (size_t)(row0 + ai * HALF + m * 16) * DEXP + col0;
                float h[8];
#pragma unroll
                for (int n = 0; n < 2; ++n)
#pragma unroll
                    for (int j = 0; j < 4; ++j) h[n * 4 + j] = silu_fast(acc[ai][0][m][n][j]) * acc[ai][1][m][n][j];
                u32x4 w; w.x = cvt_pk_bf16(h[0], h[1]); w.y = cvt_pk_bf16(h[2], h[3]); w.z = cvt_pk_bf16(h[4], h[5]); w.w = cvt_pk_bf16(h[6], h[7]);
                *(u32x4*)rowp = w; }
    }
};

template <class Epi, class Sched, bool GATHER>
__device__ __forceinline__ void gemm_phase(LAS unsigned char* lds, const Sched& S, const Epi& E) {
    const int tid = threadIdx.x, wid = __builtin_amdgcn_readfirstlane(tid >> 6), lane = tid & 63, wr = wid >> 2, wc = wid & 3, fr = lane & 15, fq = lane >> 4;
    const int K = S.K, nt = K / BK;
    unsigned voffA[2], voffB[2]; int stR[2], stC[2];
#pragma unroll
    for (int i = 0; i < 2; ++i) { int R, C; stage_rc(tid * 16 + i * 8192, R, C); const int Rb = Epi::PERM ? ((R & ~31) + perm32(R & 31)) : R;
        stR[i] = R; stC[i] = C; voffA[i] = (unsigned)(R * K + C) * 2u; voffB[i] = (unsigned)(Rb * K + C) * 2u; }
    const size_t kstep = (size_t)(BK * 2);
    const size_t hstep = (size_t)HALF * K * 2;
    const unsigned ldsw = (unsigned)wid * 1024u;
    const int aoff = lds_byte(wr * 64 + fr, fq * 8), boff = lds_byte(wc * 32 + fr, fq * 8);
#define PG8_SA(b, h) (((b) * 2 + (h)) * HTB)
#define PG8_SB(b, h) ((4 + (b) * 2 + (h)) * HTB)
#define PG8_GLDS(gp, bufoff, i) __builtin_amdgcn_global_load_lds((const unsigned*)(gp), (LAS unsigned*)(lds + (bufoff) + ldsw + (i) * 8192), 16, 0, 0)
#define PG8_STAGE_A(bufoff, sel, h, kt) do { \
        if (GATHER) { const char* _p = cA + (size_t)(kt) * kstep; PG8_GLDS(_p + ((sel) ? gN[h][0] : gC[h][0]), bufoff, 0); PG8_GLDS(_p + ((sel) ? gN[h][1] : gC[h][1]), bufoff, 1); } \
        else { const char* _p = ((sel) ? nA : cA) + (size_t)(h) * hstep + (size_t)(kt) * kstep; PG8_GLDS(_p + voffA[0], bufoff, 0); PG8_GLDS(_p + voffA[1], bufoff, 1); } } while (0)
#define PG8_STAGE_B(bufoff, sel, h, kt) do { const char* _p = ((sel) ? nB : cB) + (size_t)(h) * hstep + (size_t)(kt) * kstep; PG8_GLDS(_p + voffB[0], bufoff, 0); PG8_GLDS(_p + voffB[1], bufoff, 1); } while (0)
#define PG8_LDA(dst, b, h) do { _Pragma("unroll") for (int m = 0; m < 4; ++m) _Pragma("unroll") for (int k = 0; k < 2; ++k) dst[m][k] = *(const LAS bf16x8*)(lds + PG8_SA(b, h) + aoff + m * 2048 + k * 1024); } while (0)
#define PG8_LDB(dst, b, h) do { _Pragma("unroll") for (int n = 0; n < 2; ++n) _Pragma("unroll") for (int k = 0; k < 2; ++k) dst[n][k] = *(const LAS bf16x8*)(lds + PG8_SB(b, h) + boff + n * 2048 + k * 1024); } while (0)
#define PG8_MMA(ai, bj, At, Bt) do { __builtin_amdgcn_s_setprio(1); _Pragma("unroll") for (int m = 0; m < 4; ++m) _Pragma("unroll") for (int n = 0; n < 2; ++n) _Pragma("unroll") for (int k = 0; k < 2; ++k) \
        acc[ai][bj][m][n] = __builtin_amdgcn_mfma_f32_16x16x32_bf16(Bt[n][k], At[m][k], acc[ai][bj][m][n], 0, 0, 0); __builtin_amdgcn_s_setprio(0); } while (0)
#define PG8_WAIT_V(n) asm volatile("s_waitcnt vmcnt(" #n ")" ::: "memory")
#define PG8_WAIT_L(n) asm volatile("s_waitcnt lgkmcnt(" #n ")" ::: "memory")
#define PG8_BAR __builtin_amdgcn_s_barrier()
#define PG8_SCHED __builtin_amdgcn_sched_barrier(0)
    Unit cur, nxt; int ui = 0;
    if (!S.next(0, cur)) return;
    f32x4 acc[2][2][4][2];
#pragma unroll
    for (int a = 0; a < 2; ++a)
#pragma unroll
        for (int b = 0; b < 2; ++b)
#pragma unroll
            for (int m = 0; m < 4; ++m)
#pragma unroll
                for (int n = 0; n < 2; ++n) acc[a][b][m][n] = (f32x4){0.f, 0.f, 0.f, 0.f};
    bf16x8 At[4][2], B0[2][2], B1[2][2];
    const char* cA = S.a_base(cur); const char* cB = S.b_base(cur);
    unsigned gC[2][2] = {{0u, 0u}, {0u, 0u}}, gN[2][2] = {{0u, 0u}, {0u, 0u}};
    if (GATHER) {
#pragma unroll
        for (int h = 0; h < 2; ++h)
#pragma unroll
            for (int i = 0; i < 2; ++i) gC[h][i] = ((unsigned)S.gather_row(cur, h * HALF + stR[i]) * (unsigned)K + (unsigned)stC[i]) * 2u;
    }
    {
        const char* nA = cA; const char* nB = cB;
        PG8_STAGE_B(PG8_SB(0, 0), 0, 0, 0); PG8_STAGE_B(PG8_SB(0, 1), 0, 1, 0); PG8_STAGE_A(PG8_SA(0, 0), 0, 0, 0); PG8_STAGE_A(PG8_SA(0, 1), 0, 1, 0);
        if (wr == 1) PG8_BAR;
        PG8_WAIT_V(2); PG8_BAR;
        PG8_STAGE_B(PG8_SB(1, 0), 0, 0, 1); PG8_STAGE_A(PG8_SA(1, 0), 0, 0, 1); PG8_STAGE_B(PG8_SB(1, 1), 0, 1, 1);
        PG8_WAIT_V(6); PG8_BAR;
    }
    for (;;) {
        const bool has_next = S.next(ui + 1, nxt);
        const char* nA = has_next ? S.a_base(nxt) : cA; const char* nB = has_next ? S.b_base(nxt) : cB;
        if (GATHER) {
#pragma unroll
            for (int h = 0; h < 2; ++h)
#pragma unroll
                for (int i = 0; i < 2; ++i) gN[h][i] = has_next ? ((unsigned)S.gather_row(nxt, h * HALF + stR[i]) * (unsigned)K + (unsigned)stC[i]) * 2u : gC[h][i];
        }
        for (int t = 0; t < nt; t += 2) {
            const bool last = (t == nt - 2);
            const int kt2 = last ? 0 : t + 2, kt3 = kt2 + 1;
            PG8_LDB(B0, 0, 0); PG8_LDB(B1, 0, 1); PG8_SCHED; PG8_LDA(At, 0, 0); PG8_STAGE_A(PG8_SA(1, 1), false, 1, t + 1);
            PG8_WAIT_V(8); PG8_WAIT_L(0); PG8_BAR; PG8_MMA(0, 0, At, B0); PG8_MMA(0, 1, At, B1); PG8_BAR; PG8_SCHED;
            PG8_LDA(At, 0, 1); PG8_STAGE_B(PG8_SB(0, 0), last, 0, kt2); PG8_STAGE_B(PG8_SB(0, 1), last, 1, kt2); PG8_STAGE_A(PG8_SA(0, 0), last, 0, kt2);
            PG8_WAIT_V(8); PG8_WAIT_L(0); PG8_BAR; PG8_MMA(1, 0, At, B0); PG8_MMA(1, 1, At, B1); PG8_BAR; PG8_SCHED;
            PG8_LDB(B0, 1, 0); PG8_LDB(B1, 1, 1); PG8_SCHED; PG8_LDA(At, 1, 0); PG8_STAGE_A(PG8_SA(0, 1), last, 1, kt2);
            PG8_WAIT_V(8); PG8_WAIT_L(0); PG8_BAR; PG8_MMA(0, 0, At, B0); PG8_MMA(0, 1, At, B1); PG8_BAR; PG8_SCHED;
            PG8_LDA(At, 1, 1); PG8_STAGE_B(PG8_SB(1, 0), last, 0, kt3); PG8_STAGE_B(PG8_SB(1, 1), last, 1, kt3); PG8_STAGE_A(PG8_SA(1, 0), last, 0, kt3);
            PG8_WAIT_V(8); PG8_WAIT_L(0); PG8_BAR; PG8_MMA(1, 0, At, B0); PG8_MMA(1, 1, At, B1); PG8_BAR; PG8_SCHED;
        }
        if (wr == 0) PG8_BAR;
        E(acc, cur, wr, wc, fr, fq);
        if (!has_next) break;
#pragma unroll
        for (int a = 0; a < 2; ++a)
#pragma unroll
            for (int b = 0; b < 2; ++b)
#pragma unroll
                for (int m = 0; m < 4; ++m)
#pragma unroll
                    for (int n = 0; n < 2; ++n) acc[a][b][m][n] = (f32x4){0.f, 0.f, 0.f, 0.f};
        cur = nxt; cA = nA; cB = nB; ++ui;
        if (GATHER) {
#pragma unroll
            for (int h = 0; h < 2; ++h)
#pragma unroll
                for (int i = 0; i < 2; ++i) gC[h][i] = gN[h][i];
        }
        if (wr == 1) PG8_BAR;
    }
    PG8_WAIT_V(0);
    PG8_BAR;
#undef PG8_SA
#undef PG8_SB
#undef PG8_GLDS
#undef PG8_STAGE_A
#undef PG8_STAGE_B
#undef PG8_LDA
#undef PG8_LDB
#undef PG8_MMA
#undef PG8_WAIT_V
#undef PG8_WAIT_L
#undef PG8_BAR
#undef PG8_SCHED
}
}

#define XB_TMO      128
#define XB_XCNT(j)  (256  + 64 * (j))
#define XB_XSUB(j)  (1280 + 64 * (j))
#define XB_XGEN(j)  (2304 + 64 * (j))
#define XB_TOP      3328
#define XB_TOPGEN   3392
#define XCD_BAR_WORDS 3456
#define XB_SPIN_CAP (1u << 18)
__device__ __forceinline__ unsigned xb_ld(unsigned* p)              { return __hip_atomic_load(p, __ATOMIC_RELAXED, __HIP_MEMORY_SCOPE_AGENT); }
__device__ __forceinline__ unsigned xb_add(unsigned* p, unsigned v) { return __hip_atomic_fetch_add(p, v, __ATOMIC_RELAXED, __HIP_MEMORY_SCOPE_AGENT); }
__device__ __forceinline__ unsigned xb_xcc_id() { return (unsigned)__builtin_amdgcn_s_getreg((3 << 11) | 20) & 0xFu; }
#define XB_SPIN(cond, bar) do { unsigned _sp = 0; while (cond) { __builtin_amdgcn_s_sleep(1); \
    if ((++_sp & 255u) == 0u) { if (xb_ld(&(bar)[XB_TMO])) break; if (_sp > XB_SPIN_CAP) { atomicAdd(&(bar)[XB_TMO], 1u); break; } } } } while (0)
struct XcdBarrier { unsigned* bar; unsigned x; volatile LAS unsigned* st; };
__device__ __forceinline__ XcdBarrier xcd_barrier_post(unsigned* bar, volatile LAS unsigned* st) {
    XcdBarrier b; b.bar = bar; b.x = xb_xcc_id(); b.st = st;
    if (threadIdx.x == 0) (void)xb_add(&bar[XB_XCNT(b.x)], 1u);
    return b;
}
__device__ __forceinline__ void xcd_barrier_complete(unsigned* bar, unsigned x, unsigned& nloc, unsigned& nx) {
    const unsigned G = gridDim.x * gridDim.y * gridDim.z;
    unsigned sum, cnt, mine, sp = 0u;
    for (;;) {
        sum = 0u; cnt = 0u; mine = 0u;
#pragma unroll
        for (unsigned j = 0; j < 16; ++j) { const unsigned c = xb_ld(&bar[XB_XCNT(j)]); sum += c; cnt += (c > 0u) ? 1u : 0u; mine = (j == x) ? c : mine; }
        if (sum == G) break;
        __builtin_amdgcn_s_sleep(1);
        if ((++sp & 255u) == 0u) { if (xb_ld(&bar[XB_TMO])) break; if (sp > XB_SPIN_CAP) { atomicAdd(&bar[XB_TMO], 1u); break; } }
    }
    nloc = mine > 0u ? mine : 1u; nx = cnt > 0u ? cnt : 1u;
}
__device__ __forceinline__ void xcd_barrier(const XcdBarrier& b) {
    asm volatile("s_waitcnt vmcnt(0)" ::: "memory");
    __syncthreads();
    if (threadIdx.x == 0) {
        unsigned* bar = b.bar;
        __builtin_amdgcn_s_waitcnt(0);
        unsigned nloc = b.st[0], nx = b.st[1];
        if (nloc == 0u) { xcd_barrier_complete(bar, b.x, nloc, nx); b.st[0] = nloc; b.st[1] = nx; }
        const unsigned old = xb_add(&bar[XB_XSUB(b.x)], 1u);
        const unsigned gen = old / nloc;
        if (old + 1u == (gen + 1u) * nloc) {
            __builtin_amdgcn_fence(__ATOMIC_RELEASE, "agent");
            asm volatile("s_waitcnt vmcnt(0)" ::: "memory");
            const unsigned og = xb_add(&bar[XB_TOP], 1u);
            const unsigned tg = og / nx;
            if (og + 1u == (tg + 1u) * nx) xb_add(&bar[XB_TOPGEN], 1u);
            else XB_SPIN(xb_ld(&bar[XB_TOPGEN]) == tg, bar);
            __builtin_amdgcn_fence(__ATOMIC_ACQUIRE, "agent");
            xb_add(&bar[XB_XGEN(b.x)], 1u);
            asm volatile("s_waitcnt vmcnt(0)" ::: "memory");
        } else {
            XB_SPIN(xb_ld(&bar[XB_XGEN(b.x)]) == gen, bar);
            __builtin_amdgcn_fence(__ATOMIC_ACQUIRE, "agent");
            asm volatile("s_waitcnt vmcnt(0)" ::: "memory");
        }
    }
    __syncthreads();
}

__device__ __forceinline__ float wave_sum(float v) {
#pragma unroll
    for (int o = 1; o < 64; o <<= 1) v += __shfl_xor(v, o);
    return v;
}
__device__ __forceinline__ float wave_max(float v) {
#pragma unroll
    for (int o = 1; o < 64; o <<= 1) v = fmaxf(v, __shfl_xor(v, o));
    return v;
}
__device__ __forceinline__ unsigned f2bf(float f) { unsigned u = __builtin_bit_cast(unsigned, f); return (u + 0x7fffu + ((u >> 16) & 1u)) >> 16; }
__device__ __forceinline__ unsigned pk2(float lo, float hi) { return f2bf(lo) | (f2bf(hi) << 16); }
__device__ __forceinline__ float bf2f(bf16_t b) { return __builtin_bit_cast(float, (unsigned)b << 16); }
__device__ __forceinline__ float bflo(unsigned w) { return __builtin_bit_cast(float, w << 16); }
__device__ __forceinline__ float bfhi(unsigned w) { return __builtin_bit_cast(float, w & 0xffff0000u); }
__device__ __forceinline__ float siluf(float x) { return x / (1.0f + expf(-x)); }
__device__ __forceinline__ float sigmf(float x) { return 1.0f / (1.0f + expf(-x)); }
__device__ __forceinline__ float gelu_tanh(float x) { return 0.5f * x * (1.0f + tanhf(0.7978845608028654f * (x + 0.044715f * x * x * x))); }
__device__ __forceinline__ float block_sum(float v, LAS float* red) {
    v = wave_sum(v);
    __syncthreads();
    if ((threadIdx.x & 63) == 0) red[threadIdx.x >> 6] = v;
    __syncthreads();
    float s = 0.f;
#pragma unroll
    for (int i = 0; i < 8; ++i) s += red[i];
    return s;
}

struct Params { const float* in[33]; float* out; unsigned char* ws; int ph_lo, ph_hi; };
enum { I_X = 0, I_C, I_CTX, I_CCTX, I_ADAW, I_ADAB, I_NMIX, I_NFFN, I_ONORM, I_WOUT, I_WAB, I_QN, I_KN, I_SINK, I_SCW, I_SCB, I_WCD, I_POOLW, I_POOLS,
       I_LCW, I_LCB, I_LWA, I_LBA, I_LWX, I_LBX, I_LAM, I_RGW, I_RGB, I_REW, I_REB, I_W1, I_W3, I_W2 };

__device__ __forceinline__ void transpose_item(const float* W, int N, int K, bf16_t* WT, int kb, int n0, int row_off, const float* gain, LAS float* scr, int lane) {
    const int k0 = 64 * kb;
#pragma unroll 8
    for (int i = 0; i < 32; ++i) { const int kk = 2 * i + (lane >> 5); float w = W[(size_t)(k0 + kk) * N + n0 + (lane & 31)]; if (gain) w *= gain[k0 + kk]; scr[kk * 33 + (lane & 31)] = w; }
    asm volatile("s_waitcnt lgkmcnt(0)" ::: "memory");
    const int c = lane & 7;
#pragma unroll
    for (int j = 0; j < 4; ++j) { const int n = (lane >> 3) + 8 * j; const LAS float* s = scr + (8 * c) * 33 + n;
        u32x4 o; o.x = pk2(s[0 * 33], s[1 * 33]); o.y = pk2(s[2 * 33], s[3 * 33]); o.z = pk2(s[4 * 33], s[5 * 33]); o.w = pk2(s[6 * 33], s[7 * 33]);
        *(u32x4*)(WT + (size_t)(row_off + n) * K + k0 + 8 * c) = o; }
    asm volatile("s_waitcnt lgkmcnt(0)" ::: "memory");
}
__device__ __forceinline__ void convert_experts(const float* w1, const float* w3, const float* w2, bf16_t* W13T, bf16_t* W2T, LAS float* scr, int gw, int NGW, int lane) {
    constexpr int I13 = NEXP * 16 * 16, I2 = NEXP * 8 * 32;
    for (int it = gw; it < 2 * I13 + I2; it += NGW) {
        if (it < 2 * I13) { const int which = it / I13, r = it % I13, e = r / 256, q = r % 256, kb = q / 16, nb = q % 16, n0 = nb * 32;
            const float* W = (which ? w3 : w1) + (size_t)e * DM * DEXP;
            transpose_item(W, DEXP, DM, W13T + (size_t)e * DM * DM, kb, n0, (n0 / 128) * 256 + which * 128 + (n0 % 128), nullptr, scr, lane); }
        else { const int r = it - 2 * I13, e = r / 256, q = r % 256, kb = q / 32, nb = q % 32;
            transpose_item(w2 + (size_t)e * DEXP * DM, DM, DEXP, W2T + (size_t)e * DM * DEXP, kb, nb * 32, nb * 32, nullptr, scr, lane); }
    }
}
__device__ __forceinline__ void router_row(const f32x4 (&tk)[4], int lane, const float* gw, const float* gb, const float* ew, const float* eb, int& ea, int& eb2, float& w0, float& w1) {
    float lg[36];
#pragma unroll
    for (int i = 0; i < 36; ++i) lg[i] = 0.f;
#pragma unroll
    for (int j = 0; j < 4; ++j)
#pragma unroll
        for (int q = 0; q < 4; ++q) {
            const int k = 4 * lane + 256 * j + q; const float t = tk[j][q];
            const f32x4 g4 = *(const f32x4*)(gw + k * 4);
#pragma unroll
            for (int i = 0; i < 4; ++i) lg[i] += t * g4[i];
#pragma unroll
            for (int c8 = 0; c8 < 8; ++c8) { const f32x4 e4 = *(const f32x4*)(ew + k * 32 + c8 * 4);
#pragma unroll
                for (int i = 0; i < 4; ++i) lg[4 + c8 * 4 + i] += t * e4[i]; }
        }
#pragma unroll
    for (int i = 0; i < 36; ++i) lg[i] = wave_sum(lg[i]) + (i < 4 ? gb[i] : eb[i - 4]);
    int gi = 0; float gm = lg[0];
#pragma unroll
    for (int j = 1; j < 4; ++j) if (lg[j] > gm) { gm = lg[j]; gi = j; }
    float gs = 0.f;
#pragma unroll
    for (int j = 0; j < 4; ++j) gs += expf(lg[j] - gm);
    const float p_sel = 1.0f / gs;
    float el[8];
#pragma unroll
    for (int j = 0; j < 8; ++j) el[j] = gi == 0 ? lg[4 + j] : gi == 1 ? lg[12 + j] : gi == 2 ? lg[20 + j] : lg[28 + j];
    int i0 = 0; float m0 = el[0];
#pragma unroll
    for (int j = 1; j < 8; ++j) if (el[j] > m0) { m0 = el[j]; i0 = j; }
    int i1 = 0; float m1 = -INFINITY;
#pragma unroll
    for (int j = 0; j < 8; ++j) if (j != i0 && el[j] > m1) { m1 = el[j]; i1 = j; }
    const float e1 = expf(m1 - m0);
    w0 = p_sel / (1.0f + e1); w1 = p_sel * e1 / (1.0f + e1); ea = gi * 8 + i0; eb2 = gi * 8 + i1;
}
__device__ __forceinline__ void modulate_row(const f32x4 (&v)[4], int lane, const float* g, const float* sh, const float* sc, bf16_t* orow, f32x4 (&o)[4]) {
    float ss = 0.f;
#pragma unroll
    for (int j = 0; j < 4; ++j) ss += (v[j].x * v[j].x + v[j].y * v[j].y) + (v[j].z * v[j].z + v[j].w * v[j].w);
    const float rs = rsqrtf(wave_sum(ss) * (1.0f / DM) + EPSF);
#pragma unroll
    for (int j = 0; j < 4; ++j) { const int c = 4 * lane + 256 * j;
        const f32x4 gg = *(const f32x4*)(g + c), s1 = *(const f32x4*)(sc + c), s0 = *(const f32x4*)(sh + c);
        o[j] = v[j] * rs * gg * (1.0f + s1) + s0;
        u32x2 w; w.x = pk2(o[j].x, o[j].y); w.y = pk2(o[j].z, o[j].w);
        *(u32x2*)(orow + c) = w; }
}
__device__ __forceinline__ void moe_table(const unsigned* counts, LAS int* tab) {
    if (threadIdx.x == 0) {
        int mt = 0;
        for (int e = 0; e < NEXP; ++e) { tab[1 + e] = mt * 256; const int n = ((int)counts[e] + 255) >> 8; for (int i = 0; i < n && mt < MAX_MT; ++i) tab[64 + mt++] = e; }
        tab[0] = mt;
    }
    __syncthreads();
}

__global__ void __launch_bounds__(NTHR, 2) mk_fwd(Params p) {
    extern __shared__ __attribute__((aligned(16))) unsigned char lds_raw[];
    LAS unsigned char* lds = (LAS unsigned char*)lds_raw;
    const int tid = threadIdx.x, lane = tid & 63, wave = __builtin_amdgcn_readfirstlane(tid >> 6);
    const int G = gridDim.x, bx = blockIdx.x, gw = bx * NWAVES + wave, NGW = G * NWAVES;
    unsigned char* ws = p.ws;
    unsigned* ctl = (unsigned*)(ws + WS_CTL);
    for (int u = tid; u < (LDS_BYTES - LDSCTL_OFF) / 4; u += NTHR) ((LAS unsigned*)(lds + LDSCTL_OFF))[u] = 0u;
    __syncthreads();
    XcdBarrier bar; bar.bar = ctl + CW_BAR; bar.x = 0; bar.st = nullptr;
    if (!MK_PER_PHASE) bar = xcd_barrier_post(ctl + CW_BAR, (volatile LAS unsigned*)(lds + LDSCTL_OFF + 32));
    const int lo = p.ph_lo, hi = p.ph_hi;
#define IN(k) (lo <= (k) && (k) < hi)
#define SEAM(k) do { if ((k) + 1 < hi) xcd_barrier(bar); } while (0)

    float* mods = (float*)(ws + WS_MODS);
    int* eidx = (int*)(ws + WS_EIDX); float* ewt = (float*)(ws + WS_EWT); int* tok_slot = (int*)(ws + WS_TOKSLOT); int* slot_tok = (int*)(ws + WS_SLOTTOK);
    bf16_t* WabT = (bf16_t*)(ws + WS_WAB); bf16_t* WoutT = (bf16_t*)(ws + WS_WOUT); bf16_t* WcdT = (bf16_t*)(ws + WS_WCD);
    bf16_t* W13T = (bf16_t*)(ws + WS_W13); bf16_t* W2T = (bf16_t*)(ws + WS_W2);
    bf16_t* hbuf = (bf16_t*)(ws + WS_HBUF); bf16_t* zb = (bf16_t*)(ws + WS_Z); bf16_t* ybuf = (bf16_t*)(ws + WS_YBUF);
    float* xbuf = (float*)(ws + WS_XBUF); bf16_t* Hb = (bf16_t*)(ws + WS_H); bf16_t* Yb = (bf16_t*)(ws + WS_Y);
    float* Sa = (float*)(ws + WS_S); float* Sb = Sa + (size_t)NR * 512; float* hlat = (float*)(ws + WS_HLAT);
    LAS float* scrw = (LAS float*)(lds + 32768 + wave * 8704);
    LAS int* mtab = (LAS int*)(lds + LDS_MOE_OFF);

    if (IN(0)) {
        {
            LAS float* sil = (LAS float*)lds; LAS float* red = (LAS float*)(lds + 20480);
            for (int i = tid; i < 5 * DM; i += NTHR) { const int r = i >> 10, k = i & 1023; sil[i] = siluf(r < 4 ? p.in[I_C][r * DM + k] : p.in[I_CCTX][k]); }
            __syncthreads();
            for (int item = bx; item < 192; item += G) {
                const int l = item / 96, nb = item % 96, n = nb * 64 + lane;
                const float* W = p.in[I_ADAW] + (size_t)l * DM * 6144 + (size_t)(wave * 128) * 6144 + n;
                float a[5] = {0.f, 0.f, 0.f, 0.f, 0.f};
#pragma unroll 8
                for (int k = 0; k < 128; ++k) { const float w = W[(size_t)k * 6144];
#pragma unroll
                    for (int r = 0; r < 5; ++r) a[r] += sil[r * DM + wave * 128 + k] * w; }
#pragma unroll
                for (int r = 0; r < 5; ++r) red[(wave * 5 + r) * 64 + lane] = a[r];
                __syncthreads();
                if (tid < 320) { const int r = tid >> 6; float s = 0.f;
#pragma unroll
                    for (int w = 0; w < 8; ++w) s += red[(w * 5 + r) * 64 + lane];
                    mods[((size_t)l * 5 + r) * 6144 + nb * 64 + lane] = s + p.in[I_ADAB][l * 6144 + nb * 64 + lane]; }
                __syncthreads();
            }
        }
        {
            constexpr int I_AB = 16 * 72, I_O = 16 * 32, I_CDn = 16 * 48;
            for (int it = gw; it < I_AB + 2 * I_O + I_CDn; it += NGW) {
                int r = it;
                if (r < I_AB) { transpose_item(p.in[I_WAB], IN_AB, DM, WabT, r / 72, (r % 72) * 32, (r % 72) * 32, nullptr, scrw, lane); continue; } r -= I_AB;
                if (r < 2 * I_O) { const int l = r / I_O, q = r % I_O; transpose_item(p.in[I_WOUT] + (size_t)l * DM * DM, DM, DM, WoutT + (size_t)l * DM * DM, q / 32, (q % 32) * 32, (q % 32) * 32, p.in[I_ONORM] + l * DM, scrw, lane); continue; } r -= 2 * I_O;
                transpose_item(p.in[I_WCD], IN_CD, DM, WcdT, r / 48, (r % 48) * 32, (r % 48) * 32, nullptr, scrw, lane);
            }
        }
        convert_experts(p.in[I_W1], p.in[I_W3], p.in[I_W2], W13T, W2T, scrw, gw, NGW, lane);
        for (int i = bx * NTHR + tid; i < NSLOT; i += G * NTHR) slot_tok[i] = NR;
        if (bx == 0) for (int i = tid; i < DM / 2; i += NTHR) ((unsigned*)(hbuf + (size_t)NR * DM))[i] = 0u;
        SEAM(0);
    }
    if (IN(1)) {
        for (int row = gw; row < NR; row += NGW) {
            const float* src = row < NT ? p.in[I_X] + (size_t)row * DM : p.in[I_CTX] + (size_t)(row - NT) * DM;
            const int b = row < NT ? (row >> 12) : 4;
            f32x4 v[4], o[4];
#pragma unroll
            for (int j = 0; j < 4; ++j) v[j] = *(const f32x4*)(src + 4 * lane + 256 * j);
            modulate_row(v, lane, p.in[I_NMIX], mods + (size_t)b * 6144, mods + (size_t)b * 6144 + DM, hbuf + (size_t)row * DM, o);
        }
        SEAM(1);
    }
    if (IN(2)) {
        pg8::DenseOrder S; S.init(hbuf, WabT, NR, IN_AB, DM, G, bx);
        pg8::EpiBf16 E{zb, IN_AB};
        pg8::gemm_phase<pg8::EpiBf16, pg8::DenseOrder, false>(lds, S, E);
        SEAM(2);
    }
    if (IN(3)) {
        for (int it = gw; it < NR * 10; it += NGW) {
            const int row = it / 10, hs = it % 10;
            const int col = hs < 8 ? 256 + hs * 64 : (hs - 8) * 64;
            const float* gain = hs < 8 ? p.in[I_QN] : p.in[I_KN];
            bf16_t* pz = zb + (size_t)row * IN_AB + col + lane;
            const float v = bf2f(*pz);
            const float ss = wave_sum(v * v);
            float y = v * rsqrtf(ss * (1.0f / 64.0f) + EPSF) * gain[lane];
            if (row < NT) {
                const int t = row & (SEQL - 1), r = t >> 6, c = t & 63;
                const int a = lane >> 5, half = (lane >> 4) & 1, i = lane & 15;
                const float inv = powf(10000.0f, -(float)i / 16.0f);
                const float ang = (float)(a == 0 ? r : c) * inv;
                const float cs = cosf(ang), sn = sinf(ang);
                const float partner = __shfl_xor(y, 16);
                y = half == 0 ? y * cs - partner * sn : y * cs + partner * sn;
            }
            *pz = (bf16_t)f2bf(y);
        }
        SEAM(3);
    }
    if (IN(4)) {
        LAS float* ps = (LAS float*)(lds + wave * 4096);
        LAS float* qs = ps + 640;
        for (int it = gw; it < NR * 8; it += NGW) {
            const int row = it >> 3, head = it & 7, kvh = head >> 2;
            qs[lane] = bf2f(zb[(size_t)row * IN_AB + 256 + head * 64 + lane]);
            int nloc, loc0, ctx0;
            if (row < NT) { const int b = row >> 12, t = row & (SEQL - 1); const int l0 = max(t - 128, 0), h0 = min(t + 128, SEQL - 1); nloc = h0 - l0 + 1; loc0 = b * SEQL + l0; ctx0 = NT + b * CTXL; }
            else { const int b = (row - NT) >> 8; nloc = 0; loc0 = 0; ctx0 = NT + b * CTXL; }
            const int nk = nloc + CTXL;
            const float snk = p.in[I_SINK][head];
            float mx = snk;
            for (int i = lane; i < nk; i += 64) {
                const int krow = i < nloc ? loc0 + i : ctx0 + (i - nloc);
                const u32x4* kp = (const u32x4*)(zb + (size_t)krow * IN_AB + kvh * 64);
                float d = 0.f;
#pragma unroll
                for (int j = 0; j < 8; ++j) { const u32x4 kv = kp[j];
                    d += qs[j * 8 + 0] * bflo(kv.x) + qs[j * 8 + 1] * bfhi(kv.x) + qs[j * 8 + 2] * bflo(kv.y) + qs[j * 8 + 3] * bfhi(kv.y)
                       + qs[j * 8 + 4] * bflo(kv.z) + qs[j * 8 + 5] * bfhi(kv.z) + qs[j * 8 + 6] * bflo(kv.w) + qs[j * 8 + 7] * bfhi(kv.w); }
                d *= 0.125f; ps[i] = d; mx = fmaxf(mx, d);
            }
            mx = wave_max(mx);
            float sum = 0.f;
            for (int i = lane; i < nk; i += 64) { const float e = expf(ps[i] - mx); ps[i] = e; sum += e; }
            sum = wave_sum(sum) + expf(snk - mx);
            float o = 0.f;
            for (int i = 0; i < nk; ++i) { const int krow = i < nloc ? loc0 + i : ctx0 + (i - nloc); o += ps[i] * bf2f(zb[(size_t)krow * IN_AB + 128 + kvh * 64 + lane]); }
            ybuf[(size_t)row * DM + head * 64 + lane] = (bf16_t)f2bf(o / sum);
        }
        SEAM(4);
    }
    if (IN(5)) {
        LAS float* red = (LAS float*)lds;
        const float* cw = p.in[I_SCW]; const float* cb = p.in[I_SCB]; const float* on = p.in[I_ONORM];
        (void)on;
        for (int row = bx; row < NR; row += G) {
            int pos, len; if (row < NT) { pos = row & (SEQL - 1); len = SEQL; } else { pos = (row - NT) & (CTXL - 1); len = CTXL; }
            bf16_t* y = ybuf + (size_t)row * DM; const int c = tid;
            const float a0 = bf2f(y[c]);
            float ss = block_sum(a0 * a0, red);
            y[c] = (bf16_t)f2bf(a0 * rsqrtf(ss * (1.0f / 512.0f) + EPSF));
            float acc = cb[c];
#pragma unroll
            for (int k = 0; k < 3; ++k) { const int pp = pos + k - 1;
                if (pp >= 0 && pp < len) { const bf16_t* zr = zb + (size_t)(row + k - 1) * IN_AB; acc += cw[k * 512 + c] * bf2f(zr[1280 + c]) * bf2f(zr[1792 + c]); } }
            const float cv = bf2f(zb[(size_t)row * IN_AB + 768 + c]) * acc;
            ss = block_sum(cv * cv, red);
            y[512 + c] = (bf16_t)f2bf(cv * rsqrtf(ss * (1.0f / 512.0f) + EPSF));
        }
        SEAM(5);
    }
    if (IN(6)) {
        pg8::DenseOrder S; S.init(ybuf, WoutT, NR, DM, DM, G, bx);
        pg8::EpiX E{p.in[I_X], p.in[I_CTX], mods + 2 * DM, xbuf};
        pg8::gemm_phase<pg8::EpiX, pg8::DenseOrder, false>(lds, S, E);
        SEAM(6);
    }
#define PH_TOKENS(L, NROWS) do { \
        const float* md = mods + (size_t)(L) * 5 * 6144; \
        for (int row = gw; row < (NROWS); row += NGW) { \
            const int b = row < NT ? (row >> 12) : 4; f32x4 v[4], o[4]; \
            _Pragma("unroll") for (int j = 0; j < 4; ++j) v[j] = *(const f32x4*)(xbuf + (size_t)row * DM + 4 * lane + 256 * j); \
            modulate_row(v, lane, p.in[I_NFFN] + (L) * DM, md + (size_t)b * 6144 + 3 * DM, md + (size_t)b * 6144 + 4 * DM, hbuf + (size_t)row * DM, o); \
            int ea, eb2; float w0, w1; \
            router_row(o, lane, p.in[I_RGW] + (L) * DM * 4, p.in[I_RGB] + (L) * 4, p.in[I_REW] + (L) * DM * 32, p.in[I_REB] + (L) * 32, ea, eb2, w0, w1); \
            if (lane == 0) { eidx[row * 2] = ea; eidx[row * 2 + 1] = eb2; ewt[row * 2] = w0; ewt[row * 2 + 1] = w1; \
                atomicAdd(ctl + CW_CNT + 64 * (L) + ea, 1u); atomicAdd(ctl + CW_CNT + 64 * (L) + eb2, 1u); } \
        } } while (0)
    if (IN(7)) { PH_TOKENS(0, NR); SEAM(7); }
#define PH_FILL(L, NROWS) do { \
        moe_table(ctl + CW_CNT + 64 * (L), mtab); \
        for (int i = bx * NTHR + tid; i < (NROWS) * 2; i += G * NTHR) { const int e = eidx[i]; \
            const int pos = (int)atomicAdd(ctl + CW_CUR + 64 * (L) + e, 1u); const int slot = mtab[1 + e] + pos; slot_tok[slot] = i >> 1; tok_slot[i] = slot; } \
        } while (0)
    if (IN(8)) { PH_FILL(0, NR); SEAM(8); }
#define PH_UP(L) do { \
        moe_table(ctl + CW_CNT + 64 * (L), mtab); \
        pg8::MoeOrder S; S.A = (const char*)hbuf; S.Bt = (const char*)W13T; S.K = DM; S.estride = (size_t)DM * DM * 2; S.nN = 4; S.G = G; S.c = bx; S.n_mt = mtab[0]; S.tile_e = mtab + 64; S.slot_tok = slot_tok; \
        pg8::EpiH E{Hb}; \
        pg8::gemm_phase<pg8::EpiH, pg8::MoeOrder, true>(lds, S, E); } while (0)
    if (IN(9)) { PH_UP(0); SEAM(9); }
#define PH_DOWN(L) do { \
        moe_table(ctl + CW_CNT + 64 * (L), mtab); \
        pg8::MoeOrder S; S.A = (const char*)Hb; S.Bt = (const char*)W2T; S.K = DEXP; S.estride = (size_t)DM * DEXP * 2; S.nN = 4; S.G = G; S.c = bx; S.n_mt = mtab[0]; S.tile_e = mtab + 64; S.slot_tok = nullptr; \
        pg8::EpiBf16 E{Yb, DM}; \
        pg8::gemm_phase<pg8::EpiBf16, pg8::MoeOrder, false>(lds, S, E); } while (0)
    if (IN(10)) { PH_DOWN(0); SEAM(10); }
    if (IN(11)) {
        const float* md1 = mods + (size_t)5 * 6144;
        for (int row = gw; row < NR; row += NGW) {
            const int b = row < NT ? (row >> 12) : 4;
            const int s0 = tok_slot[row * 2], s1 = tok_slot[row * 2 + 1]; const float w0 = ewt[row * 2], w1 = ewt[row * 2 + 1];
            f32x4 v[4], o[4];
#pragma unroll
            for (int j = 0; j < 4; ++j) { const int c = 4 * lane + 256 * j;
                const f32x4 x = *(const f32x4*)(xbuf + (size_t)row * DM + c), gt = *(const f32x4*)(mods + (size_t)b * 6144 + 5 * DM + c);
                const u32x2 y0 = *(const u32x2*)(Yb + (size_t)s0 * DM + c), y1 = *(const u32x2*)(Yb + (size_t)s1 * DM + c);
                f32x4 m; m.x = w0 * bflo(y0.x) + w1 * bflo(y1.x); m.y = w0 * bfhi(y0.x) + w1 * bfhi(y1.x); m.z = w0 * bflo(y0.y) + w1 * bflo(y1.y); m.w = w0 * bfhi(y0.y) + w1 * bfhi(y1.y);
                v[j] = x + gt * m;
                *(f32x4*)(xbuf + (size_t)row * DM + c) = v[j]; }
            modulate_row(v, lane, p.in[I_NMIX] + DM, md1 + (size_t)b * 6144, md1 + (size_t)b * 6144 + DM, hbuf + (size_t)row * DM, o);
        }
        convert_experts(p.in[I_W1] + (size_t)NEXP * DM * DEXP, p.in[I_W3] + (size_t)NEXP * DM * DEXP, p.in[I_W2] + (size_t)NEXP * DEXP * DM, W13T, W2T, scrw, gw, NGW, lane);
        for (int i = bx * NTHR + tid; i < NSLOT; i += G * NTHR) slot_tok[i] = NR;
        SEAM(11);
    }
    if (IN(12)) {
        pg8::DenseOrder S; S.init(hbuf, WcdT, NR, IN_CD, DM, G, bx);
        pg8::EpiBf16 E{zb, IN_CD};
        pg8::gemm_phase<pg8::EpiBf16, pg8::DenseOrder, false>(lds, S, E);
        SEAM(12);
    }
#define PH_GATES(d) do { \
        LAS float* xl = (LAS float*)lds; const int c = tid, h = c >> 6, jj = c & 63; \
        const float* wap = p.in[I_LWA] + ((size_t)((d) * 8 + h) * 64) * 64 + jj; const float* wxp = p.in[I_LWX] + ((size_t)((d) * 8 + h) * 64) * 64 + jj; \
        const float nl = -p.in[I_LAM][(d) * 512 + c]; const float sp = nl > 20.f ? nl : log1pf(expf(nl)); \
        for (int row = bx; row < NR; row += G) { \
            int pos, len; if (row < NT) { pos = row & (SEQL - 1); len = SEQL; } else { pos = (row - NT) & (CTXL - 1); len = CTXL; } \
            float acc = p.in[I_LCB][c]; \
            _Pragma("unroll") for (int k = 0; k < 4; ++k) { const int pp = pos + k - 2; if (pp >= 0 && pp < len) acc += p.in[I_LCW][k * 512 + c] * bf2f(zb[(size_t)(row + k - 2) * IN_CD + c]); } \
            __syncthreads(); xl[c] = acc; __syncthreads(); \
            float ra = 0.f, rx = 0.f; \
            for (int i = 0; i < 64; ++i) { const float u = xl[h * 64 + i]; ra += u * wap[i * 64]; rx += u * wxp[i * 64]; } \
            const float r = sigmf(ra + p.in[I_LBA][(d) * 512 + c]), gi = sigmf(rx + p.in[I_LBX][(d) * 512 + c]); \
            const float log_a = -8.0f * sp * r; \
            Sa[(size_t)row * 512 + c] = expf(log_a); Sb[(size_t)row * 512 + c] = sqrtf(-expm1f(2.0f * log_a)) * gi * acc; \
        } } while (0)
    if (IN(13)) { PH_GATES(0); SEAM(13); }
    if (IN(14)) {
        const int i = bx * NTHR + tid;
        if (i < 4 * 512) { const int b = i >> 9, c = i & 511; float h = 0.f;
            for (int t = 0; t < CTXL; ++t) { const size_t r = (size_t)(NT + b * CTXL + t) * 512 + c; h = Sa[r] * h + Sb[r]; }
            for (int t = 0; t < SEQL; ++t) { const size_t r = (size_t)(b * SEQL + t) * 512 + c; h = Sa[r] * h + Sb[r]; hlat[r] = h; } }
        SEAM(14);
    }
    if (IN(15)) { PH_GATES(1); SEAM(15); }
    if (IN(16)) {
        const int i = bx * NTHR + tid;
        if (i < 4 * 512) { const int b = i >> 9, c = i & 511; float h = 0.f;
            for (int t = CTXL - 1; t >= 0; --t) { const size_t r = (size_t)(NT + b * CTXL + t) * 512 + c; h = Sa[r] * h + Sb[r]; }
            for (int t = SEQL - 1; t >= 0; --t) { const size_t r = (size_t)(b * SEQL + t) * 512 + c; h = Sa[r] * h + Sb[r]; hlat[r] += h; } }
        SEAM(16);
    }
    if (IN(17)) {
        LAS float* red = (LAS float*)lds; LAS float* dp = (LAS float*)(lds + 64);
        const int c = tid, g = c >> 7, w = 2 << g, j = c & 127;
        const float* pw = p.in[I_POOLW] + (size_t)g * 128 * 128 + j; const float psc = p.in[I_POOLS][c];
        for (int row = bx; row < NT; row += G) {
            const int t = row & (SEQL - 1); const int l0 = max(t - w / 2, 0), h0 = min(t + w / 2, SEQL);
            float s = 0.f;
            for (int q = l0; q < h0; ++q) s += bf2f(zb[(size_t)(row - t + q) * IN_CD + 1024 + c]);
            __syncthreads();
            dp[c] = s / (float)(h0 - l0) - bf2f(zb[(size_t)row * IN_CD + 1024 + c]);
            __syncthreads();
            float y = 0.f;
            for (int i = 0; i < 128; ++i) y += dp[g * 128 + i] * pw[i * 128];
            y *= psc;
            float ss = block_sum(y * y, red);
            ybuf[(size_t)row * DM + c] = (bf16_t)f2bf(y * rsqrtf(ss * (1.0f / 512.0f) + EPSF));
            const float v = hlat[(size_t)row * 512 + c] * gelu_tanh(bf2f(zb[(size_t)row * IN_CD + 512 + c]));
            ss = block_sum(v * v, red);
            ybuf[(size_t)row * DM + 512 + c] = (bf16_t)f2bf(v * rsqrtf(ss * (1.0f / 512.0f) + EPSF));
        }
        SEAM(17);
    }
    if (IN(18)) {
        pg8::DenseOrder S; S.init(ybuf, WoutT + (size_t)DM * DM, NT, DM, DM, G, bx);
        pg8::EpiX E{xbuf, xbuf + (size_t)NT * DM, mods + (size_t)5 * 6144 + 2 * DM, xbuf};
        pg8::gemm_phase<pg8::EpiX, pg8::DenseOrder, false>(lds, S, E);
        SEAM(18);
    }
    if (IN(19)) { PH_TOKENS(1, NT); SEAM(19); }
    if (IN(20)) { PH_FILL(1, NT); SEAM(20); }
    if (IN(21)) { PH_UP(1); SEAM(21); }
    if (IN(22)) { PH_DOWN(1); SEAM(22); }
    if (IN(23)) {
        const float* md1 = mods + (size_t)5 * 6144;
        for (int row = gw; row < NT; row += NGW) {
            const int b = row >> 12;
            const int s0 = tok_slot[row * 2], s1 = tok_slot[row * 2 + 1]; const float w0 = ewt[row * 2], w1 = ewt[row * 2 + 1];
#pragma unroll
            for (int j = 0; j < 4; ++j) { const int c = 4 * lane + 256 * j;
                const f32x4 x = *(const f32x4*)(xbuf + (size_t)row * DM + c), gt = *(const f32x4*)(md1 + (size_t)b * 6144 + 5 * DM + c);
                const u32x2 y0 = *(const u32x2*)(Yb + (size_t)s0 * DM + c), y1 = *(const u32x2*)(Yb + (size_t)s1 * DM + c);
                f32x4 m; m.x = w0 * bflo(y0.x) + w1 * bflo(y1.x); m.y = w0 * bfhi(y0.x) + w1 * bfhi(y1.x); m.z = w0 * bflo(y0.y) + w1 * bflo(y1.y); m.w = w0 * bfhi(y0.y) + w1 * bfhi(y1.y);
                *(f32x4*)(p.out + (size_t)row * DM + c) = x + gt * m; }
        }
    }
#undef IN
#undef SEAM
}
constexpr int NPH = 24;

extern "C" void kernel_launch(void* const* d_in, const int* in_sizes, int n_in, void* d_out, int out_size, void* d_ws, size_t ws_size, hipStream_t stream) {
    static int grid = 0;
    if (grid == 0) {
        if (n_in != 33 || ws_size < WS_END) { fprintf(stderr, "kernel_launch: unexpected n_in %d or ws_size %zu (< %zu)\n", n_in, ws_size, (size_t)WS_END); grid = -1; return; }
        int dev = 0, cus = 0, per_cu = 0;
        if (hipGetDevice(&dev) != hipSuccess || hipDeviceGetAttribute(&cus, hipDeviceAttributeMultiprocessorCount, dev) != hipSuccess) { grid = -1; return; }
        if (hipFuncSetAttribute((const void*)mk_fwd, hipFuncAttributeMaxDynamicSharedMemorySize, LDS_BYTES) != hipSuccess) { fprintf(stderr, "kernel_launch: hipFuncSetAttribute failed\n"); grid = -1; return; }
        if (hipOccupancyMaxActiveBlocksPerMultiprocessor(&per_cu, (const void*)mk_fwd, NTHR, LDS_BYTES) != hipSuccess || per_cu < 1)
            fprintf(stderr, "kernel_launch: occupancy query reports %d workgroups per CU\n", per_cu);
        (void)hipGetLastError();
        grid = cus;
    }
    if (grid < 0) return;
    (void)in_sizes; (void)out_size;
    if (hipMemsetAsync((char*)d_ws + WS_CTL, 0, CTL_ZERO_BYTES, stream) != hipSuccess) return;
    Params a{};
    for (int i = 0; i < 33; ++i) a.in[i] = (const float*)d_in[i];
    a.out = (float*)d_out; a.ws = (unsigned char*)d_ws;
#if MK_PER_PHASE
    for (int ph = 0; ph < NPH; ++ph) { a.ph_lo = ph; a.ph_hi = ph + 1; hipLaunchKernelGGL(mk_fwd, dim3(grid), dim3(NTHR), LDS_BYTES, stream, a); }
#else
    a.ph_lo = 0; a.ph_hi = NPH;
    hipLaunchKernelGGL(mk_fwd, dim3(grid), dim3(NTHR), LDS_BYTES, stream, a);
#endif
}
```

```cpp
#include <hip/hip_runtime.h>
#include <cstdio>
#include <cstdint>

#define LAS __attribute__((address_space(3)))
#define GAS __attribute__((address_space(1)))
typedef unsigned short bf16_t;
typedef short bf16x8 __attribute__((ext_vector_type(8)));
typedef float f32x4 __attribute__((ext_vector_type(4)));
typedef float f32x2 __attribute__((ext_vector_type(2)));
typedef unsigned u32x4 __attribute__((ext_vector_type(4)));
typedef unsigned u32x2 __attribute__((ext_vector_type(2)));
typedef float f32x16 __attribute__((ext_vector_type(16)));
typedef __bf16 bf16x2_t __attribute__((ext_vector_type(2)));
__device__ __forceinline__ unsigned pkbf(float a, float b) { f32x2 v = {a, b}; return __builtin_bit_cast(unsigned, __builtin_convertvector(v, bf16x2_t)); }
#define MFMA32(a, b, c) __builtin_amdgcn_mfma_f32_32x32x16_bf16((a), (b), (c), 0, 0, 0)

#ifndef MK_PER_PHASE
#define MK_PER_PHASE 0
#endif

constexpr int DM = 1024, SEQL = 4096, NT = 16384, CTXL = 256, NCX = 1024, NR = 17408;
constexpr int IN_AB = 2304, IN_CD = 1536, NEXP = 32, DEXP = 512;
constexpr float EPSF = 1e-6f;
constexpr int MAX_MT = 168, NSLOT = MAX_MT * 256;
constexpr int NWAVES = 8, NTHR = 512;

constexpr size_t MiB = 1u << 20;
constexpr size_t WS_CTL = 0, CTL_ZERO_BYTES = 1 * MiB;
constexpr size_t WS_LRUW = 1 * MiB + 512 * 1024;
constexpr size_t WS_MODS = 1 * MiB, WS_EIDX = 2 * MiB, WS_EWT = 3 * MiB, WS_TOKSLOT = 4 * MiB, WS_SLOTTOK = 5 * MiB;
constexpr size_t WS_WAB = 6 * MiB, WS_WOUT = 11 * MiB, WS_WCD = 15 * MiB, WS_W13 = 18 * MiB, WS_W2 = 82 * MiB;
constexpr size_t WS_HBUF = 114 * MiB, WS_Z = 149 * MiB, WS_YBUF = 226 * MiB, WS_XBUF = 260 * MiB, WS_H = 328 * MiB, WS_S = 370 * MiB, WS_END = 438 * MiB;
constexpr size_t WS_Y = WS_Z;
constexpr size_t WS_HLAT = WS_H;
constexpr int CW_BAR = 4096, CW_CNT = 8192, CW_CUR = 8192 + 128;

constexpr int RING_BYTES = 131072, LDSCTL_OFF = 147456, LDS_MOE_OFF = LDSCTL_OFF + 512, LDS_BYTES = 151552;

namespace pg8 {
constexpr int BM = 256, BK = 64, HALF = 128, HTB = HALF * BK * 2, NXCD = 8, WGM = 8;
__host__ __device__ __forceinline__ int lds_byte(int r, int c) { const int st = (r >> 4) * 2 + (c >> 5), rr = r & 15, cc = c & 31, ob = rr * 64 + cc * 2; return st * 1024 + (ob ^ (((ob >> 9) & 1) << 5)); }
__host__ __device__ __forceinline__ void stage_rc(int b, int& R, int& C) { const int st = b / 1024, sb = b % 1024, swz = sb ^ (((sb >> 9) & 1) << 5); R = (st >> 1) * 16 + swz / 64; C = (st & 1) * 32 + (swz % 64) / 2; }
__host__ __device__ __forceinline__ int perm32(int rho) { const int n = rho >> 4, i = rho & 15; return 8 * (i >> 2) + 4 * n + (i & 3); }
struct Unit { int pm, pn, e; };

struct DenseOrder {
    const char* A; const char* Bt; int K, nM, nN, nwg, G, c;
    __device__ void init(const void* A_, const void* Bt_, int M, int N, int K_, int G_, int c_) { A = (const char*)A_; Bt = (const char*)Bt_; K = K_; nM = M / BM; nN = N / BM; nwg = nM * nN; G = G_; c = c_; }
    __device__ bool next(int i, Unit& u) const {
        const long L = (long)i * G + c; if (L >= nwg) return false;
        int wgid = (int)L; { const int q = nwg / NXCD, r = nwg % NXCD, xcd = wgid % NXCD, off = wgid / NXCD; wgid = (xcd < r ? xcd * (q + 1) : r * (q + 1) + (xcd - r) * q) + off; }
        const int nig = WGM * nN, gid = wgid / nig, fm = gid * WGM, gsz = (nM - fm) < WGM ? (nM - fm) : WGM;
        u.pm = fm + ((wgid % nig) % gsz); u.pn = (wgid % nig) / gsz; u.e = 0; return true;
    }
    __device__ __forceinline__ const char* a_base(const Unit& u) const { return A + (size_t)u.pm * BM * K * 2; }
    __device__ __forceinline__ const char* b_base(const Unit& u) const { return Bt + (size_t)u.pn * BM * K * 2; }
    __device__ __forceinline__ int gather_row(const Unit&, int) const { return 0; }
};
struct MoeOrder {
    const char* A; const char* Bt; int K; size_t estride; int nN, G, c, n_mt; const LAS int* tile_e; const int* slot_tok;
    __device__ bool next(int i, Unit& u) const { const long L = (long)i * G + c; if (L >= (long)n_mt * nN) return false; u.pm = (int)(L / nN); u.pn = (int)(L % nN); u.e = tile_e[u.pm]; return true; }
    __device__ __forceinline__ const char* a_base(const Unit& u) const { return slot_tok ? A : A + (size_t)u.pm * BM * K * 2; }
    __device__ __forceinline__ const char* b_base(const Unit& u) const { return Bt + (size_t)u.e * estride + (size_t)u.pn * BM * K * 2; }
    __device__ __forceinline__ int gather_row(const Unit& u, int r) const { return slot_tok[u.pm * BM + r]; }
};

__device__ __forceinline__ unsigned cvt_pk_bf16(float lo, float hi) { unsigned r; asm volatile("v_cvt_pk_bf16_f32 %0, %1, %2" : "=v"(r) : "v"(lo), "v"(hi)); return r; }

struct EpiBf16 {
    static constexpr bool PERM = true;
    bf16_t* O; int ldc;
    __device__ __forceinline__ void operator()(const f32x4 (&acc)[2][2][4][2], const Unit& u, int wr, int wc, int fr, int fq) const {
        const int row0 = u.pm * BM + wr * 64 + fr, col0 = u.pn * BM + wc * 32 + 8 * fq;
#pragma unroll
        for (int ai = 0; ai < 2; ++ai)
#pragma unroll
            for (int m = 0; m < 4; ++m) { bf16_t* rowp = O + (size_t)(row0 + ai * HALF + m * 16) * ldc + col0;
#pragma unroll
                for (int bj = 0; bj < 2; ++bj) { const f32x4 v0 = acc[ai][bj][m][0], v1 = acc[ai][bj][m][1];
                    u32x4 w; w.x = cvt_pk_bf16(v0[0], v0[1]); w.y = cvt_pk_bf16(v0[2], v0[3]); w.z = cvt_pk_bf16(v1[0], v1[1]); w.w = cvt_pk_bf16(v1[2], v1[3]);
                    *(u32x4*)(rowp + bj * HALF) = w; } }
    }
};
struct EpiX {
    static constexpr bool PERM = false;
    const float* res_lat; const float* res_ctx; const float* gate; float* out;
    __device__ __forceinline__ void operator()(const f32x4 (&acc)[2][2][4][2], const Unit& u, int wr, int wc, int fr, int fq) const {
        const int row0 = u.pm * BM + wr * 64 + fr, col0 = u.pn * BM + wc * 32 + 4 * fq;
#pragma unroll
        for (int ai = 0; ai < 2; ++ai)
#pragma unroll
            for (int m = 0; m < 4; ++m) {
                const int row = row0 + ai * HALF + m * 16;
                const float* rp = row < NT ? res_lat + (size_t)row * DM : res_ctx + (size_t)(row - NT) * DM;
                const float* gp = gate + (size_t)(row < NT ? (row >> 12) : 4) * 6144;
                float* op = out + (size_t)row * DM;
#pragma unroll
                for (int bj = 0; bj < 2; ++bj)
#pragma unroll
                    for (int n = 0; n < 2; ++n) { const int col = col0 + bj * HALF + n * 16;
                        const f32x4 r = *(const f32x4*)(rp + col), g = *(const f32x4*)(gp + col);
                        *(f32x4*)(op + col) = r + g * acc[ai][bj][m][n]; }
            }
    }
};
__device__ __forceinline__ float silu_fast(float x) { return x * __builtin_amdgcn_rcpf(1.0f + __builtin_amdgcn_exp2f(-1.44269504f * x)); }
struct EpiH {
    static constexpr bool PERM = true;
    bf16_t* H;
    __device__ __forceinline__ void operator()(const f32x4 (&acc)[2][2][4][2], const Unit& u, int wr, int wc, int fr, int fq) const {
        const int row0 = u.pm * BM + wr * 64 + fr, col0 = u.pn * HALF + wc * 32 + 8 * fq;
#pragma unroll
        for (int ai = 0; ai < 2; ++ai)
#pragma unroll
            for (int m = 0; m < 4; ++m) { bf16_t* rowp = H + (size_t)(row0 + ai * HALF + m * 16) * DEXP + col0;
                float h[8];
#pragma unroll
                for (int n = 0; n < 2; ++n)
#pragma unroll
                    for (int j = 0; j < 4; ++j) h[n * 4 + j] = silu_fast(acc[ai][0][m][n][j]) * acc[ai][1][m][n][j];
                u32x4 w; w.x = cvt_pk_bf16(h[0], h[1]); w.y = cvt_pk_bf16(h[2], h[3]); w.z = cvt_pk_bf16(h[4], h[5]); w.w = cvt_pk_bf16(h[6], h[7]);
                *(u32x4*)rowp = w; }
    }
};

template <class Epi, class Sched, bool GATHER>
__device__ __forceinline__ void gemm_phase(LAS unsigned char* lds, const Sched& S, const Epi& E) {
    const int tid = threadIdx.x, wid = __builtin_amdgcn_readfirstlane(tid >> 6), lane = tid & 63, wr = wid >> 2, wc = wid & 3, fr = lane & 15, fq = lane >> 4;
    const int K = S.K, nt = K / BK;
    unsigned voffA[2], voffB[2]; int stR[2], stC[2];
#pragma unroll
    for (int i = 0; i < 2; ++i) { int R, C; stage_rc(tid * 16 + i * 8192, R, C); const int Rb = Epi::PERM ? ((R & ~31) + perm32(R & 31)) : R;
        stR[i] = R; stC[i] = C; voffA[i] = (unsigned)(R * K + C) * 2u; voffB[i] = (unsigned)(Rb * K + C) * 2u; }
    const size_t kstep = (size_t)(BK * 2);
    const size_t hstep = (size_t)HALF * K * 2;
    const unsigned ldsw = (unsigned)wid * 1024u;
    const int aoff = lds_byte(wr * 64 + fr, fq * 8), boff = lds_byte(wc * 32 + fr, fq * 8);
#define PG8_SA(b, h) (((b) * 2 + (h)) * HTB)
#define PG8_SB(b, h) ((4 + (b) * 2 + (h)) * HTB)
#define PG8_GLDS(gp, bufoff, i) __builtin_amdgcn_global_load_lds((const unsigned*)(gp), (LAS unsigned*)(lds + (bufoff) + ldsw + (i) * 8192), 16, 0, 0)
#define PG8_STAGE_A(bufoff, sel, h, kt) do { \
        if (GATHER) { const char* _p = cA + (size_t)(kt) * kstep; PG8_GLDS(_p + ((sel) ? gN[h][0] : gC[h][0]), bufoff, 0); PG8_GLDS(_p + ((sel) ? gN[h][1] : gC[h][1]), bufoff, 1); } \
        else { const char* _p = ((sel) ? nA : cA) + (size_t)(h) * hstep + (size_t)(kt) * kstep; PG8_GLDS(_p + voffA[0], bufoff, 0); PG8_GLDS(_p + voffA[1], bufoff, 1); } } while (0)
#define PG8_STAGE_B(bufoff, sel, h, kt) do { const char* _p = ((sel) ? nB : cB) + (size_t)(h) * hstep + (size_t)(kt) * kstep; PG8_GLDS(_p + voffB[0], bufoff, 0); PG8_GLDS(_p + voffB[1], bufoff, 1); } while (0)
#define PG8_LDA(dst, b, h) do { _Pragma("unroll") for (int m = 0; m < 4; ++m) _Pragma("unroll") for (int k = 0; k < 2; ++k) dst[m][k] = *(const LAS bf16x8*)(lds + PG8_SA(b, h) + aoff + m * 2048 + k * 1024); } while (0)
#define PG8_LDB(dst, b, h) do { _Pragma("unroll") for (int n = 0; n < 2; ++n) _Pragma("unroll") for (int k = 0; k < 2; ++k) dst[n][k] = *(const LAS bf16x8*)(lds + PG8_SB(b, h) + boff + n * 2048 + k * 1024); } while (0)
#define PG8_MMA(ai, bj, At, Bt) do { __builtin_amdgcn_s_setprio(1); _Pragma("unroll") for (int m = 0; m < 4; ++m) _Pragma("unroll") for (int n = 0; n < 2; ++n) _Pragma("unroll") for (int k = 0; k < 2; ++k) \
        acc[ai][bj][m][n] = __builtin_amdgcn_mfma_f32_16x16x32_bf16(Bt[n][k], At[m][k], acc[ai][bj][m][n], 0, 0, 0); __builtin_amdgcn_s_setprio(0); } while (0)
#define PG8_WAIT_V(n) asm volatile("s_waitcnt vmcnt(" #n ")" ::: "memory")
#define PG8_WAIT_L(n) asm volatile("s_waitcnt lgkmcnt(" #n ")" ::: "memory")
#define PG8_BAR __builtin_amdgcn_s_barrier()
#define PG8_SCHED __builtin_amdgcn_sched_barrier(0)
    Unit cur, nxt; int ui = 0;
    if (!S.next(0, cur)) return;
    f32x4 acc[2][2][4][2];
#pragma unroll
    for (int a = 0; a < 2; ++a)
#pragma unroll
        for (int b = 0; b < 2; ++b)
#pragma unroll
            for (int m = 0; m < 4; ++m)
#pragma unroll
                for (int n = 0; n < 2; ++n) acc[a][b][m][n] = (f32x4){0.f, 0.f, 0.f, 0.f};
    bf16x8 At[4][2], B0[2][2], B1[2][2];
    const char* cA = S.a_base(cur); const char* cB = S.b_base(cur);
    unsigned gC[2][2] = {{0u, 0u}, {0u, 0u}}, gN[2][2] = {{0u, 0u}, {0u, 0u}};
    if (GATHER) {
#pragma unroll
        for (int h = 0; h < 2; ++h)
#pragma unroll
            for (int i = 0; i < 2; ++i) gC[h][i] = ((unsigned)S.gather_row(cur, h * HALF + stR[i]) * (unsigned)K + (unsigned)stC[i]) * 2u;
    }
    {
        const char* nA = cA; const char* nB = cB;
        PG8_STAGE_B(PG8_SB(0, 0), 0, 0, 0); PG8_STAGE_B(PG8_SB(0, 1), 0, 1, 0); PG8_STAGE_A(PG8_SA(0, 0), 0, 0, 0); PG8_STAGE_A(PG8_SA(0, 1), 0, 1, 0);
        if (wr == 1) PG8_BAR;
        PG8_WAIT_V(2); PG8_BAR;
        PG8_STAGE_B(PG8_SB(1, 0), 0, 0, 1); PG8_STAGE_A(PG8_SA(1, 0), 0, 0, 1); PG8_STAGE_B(PG8_SB(1, 1), 0, 1, 1);
        PG8_WAIT_V(6); PG8_BAR;
    }
    for (;;) {
        const bool has_next = S.next(ui + 1, nxt);
        const char* nA = has_next ? S.a_base(nxt) : cA; const char* nB = has_next ? S.b_base(nxt) : cB;
        if (GATHER) {
#pragma unroll
            for (int h = 0; h < 2; ++h)
#pragma unroll
                for (int i = 0; i < 2; ++i) gN[h][i] = has_next ? ((unsigned)S.gather_row(nxt, h * HALF + stR[i]) * (unsigned)K + (unsigned)stC[i]) * 2u : gC[h][i];
        }
        for (int t = 0; t < nt; t += 2) {
            const bool last = (t == nt - 2);
            const int kt2 = last ? 0 : t + 2, kt3 = kt2 + 1;
            PG8_LDB(B0, 0, 0); PG8_LDB(B1, 0, 1); PG8_SCHED; PG8_LDA(At, 0, 0); PG8_STAGE_A(PG8_SA(1, 1), false, 1, t + 1);
            PG8_WAIT_V(8); PG8_WAIT_L(0); PG8_BAR; PG8_MMA(0, 0, At, B0); PG8_MMA(0, 1, At, B1); PG8_BAR; PG8_SCHED;
            PG8_LDA(At, 0, 1); PG8_STAGE_B(PG8_SB(0, 0), last, 0, kt2); PG8_STAGE_B(PG8_SB(0, 1), last, 1, kt2); PG8_STAGE_A(PG8_SA(0, 0), last, 0, kt2);
            PG8_WAIT_V(8); PG8_WAIT_L(0); PG8_BAR; PG8_MMA(1, 0, At, B0); PG8_MMA(1, 1, At, B1); PG8_BAR; PG8_SCHED;
            PG8_LDB(B0, 1, 0); PG8_LDB(B1, 1, 1); PG8_SCHED; PG8_LDA(At, 1, 0); PG8_STAGE_A(PG8_SA(0, 1), last, 1, kt2);
            PG8_WAIT_V(8); PG8_WAIT_L(0); PG8_BAR; PG8_MMA(0, 0, At, B0); PG8_MMA(0, 1, At, B1); PG8_BAR; PG8_SCHED;
            PG8_LDA(At, 1, 1); PG8_STAGE_B(PG8_SB(1, 0), last, 0, kt3); PG8_STAGE_B(PG8_SB(1, 1), last, 1, kt3); PG8_STAGE_A(PG8_SA(1, 0), last, 0, kt3);
            PG8_WAIT_V(8); PG8_WAIT_L(0); PG8_BAR; PG8_MMA(1, 0, At, B0); PG8_MMA(1, 1, At, B1); PG8_BAR; PG8_SCHED;
        }
        if (wr == 0) PG8_BAR;
        E(acc, cur, wr, wc, fr, fq);
        if (!has_next) break;
#pragma unroll
        for (int a = 0; a < 2; ++a)
#pragma unroll
            for (int b = 0; b < 2; ++b)
#pragma unroll
                for (int m = 0; m < 4; ++m)
#pragma unroll
                    for (int n = 0; n < 2; ++n) acc[a][b][m][n] = (f32x4){0.f, 0.f, 0.f, 0.f};
        cur = nxt; cA = nA; cB = nB; ++ui;
        if (GATHER) {
#pragma unroll
            for (int h = 0; h < 2; ++h)
#pragma unroll
                for (int i = 0; i < 2; ++i) gC[h][i] = gN[h][i];
        }
        if (wr == 1) PG8_BAR;
    }
    PG8_WAIT_V(0);
    PG8_BAR;
#undef PG8_SA
#undef PG8_SB
#undef PG8_GLDS
#undef PG8_STAGE_A
#undef PG8_STAGE_B
#undef PG8_LDA
#undef PG8_LDB
#undef PG8_MMA
#undef PG8_WAIT_V
#undef PG8_WAIT_L
#undef PG8_BAR
#undef PG8_SCHED
}
}

#define XB_TMO      128
#define XB_XCNT(j)  (256  + 64 * (j))
#define XB_XSUB(j)  (1280 + 64 * (j))
#define XB_XGEN(j)  (2304 + 64 * (j))
#define XB_TOP      3328
#define XB_TOPGEN   3392
#define XCD_BAR_WORDS 3456
#define XB_SPIN_CAP (1u << 18)
__device__ __forceinline__ unsigned xb_ld(unsigned* p)              { return __hip_atomic_load(p, __ATOMIC_RELAXED, __HIP_MEMORY_SCOPE_AGENT); }
__device__ __forceinline__ unsigned xb_add(unsigned* p, unsigned v) { return __hip_atomic_fetch_add(p, v, __ATOMIC_RELAXED, __HIP_MEMORY_SCOPE_AGENT); }
__device__ __forceinline__ unsigned xb_xcc_id() { return (unsigned)__builtin_amdgcn_s_getreg((3 << 11) | 20) & 0xFu; }
#define XB_SPIN(cond, bar) do { unsigned _sp = 0; while (cond) { __builtin_amdgcn_s_sleep(1); \
    if ((++_sp & 255u) == 0u) { if (xb_ld(&(bar)[XB_TMO])) break; if (_sp > XB_SPIN_CAP) { atomicAdd(&(bar)[XB_TMO], 1u); break; } } } } while (0)
struct XcdBarrier { unsigned* bar; unsigned x; volatile LAS unsigned* st; };
__device__ __forceinline__ XcdBarrier xcd_barrier_post(unsigned* bar, volatile LAS unsigned* st) {
    XcdBarrier b; b.bar = bar; b.x = xb_xcc_id(); b.st = st;
    if (threadIdx.x == 0) (void)xb_add(&bar[XB_XCNT(b.x)], 1u);
    return b;
}
__device__ __forceinline__ void xcd_barrier_complete(unsigned* bar, unsigned x, unsigned& nloc, unsigned& nx) {
    const unsigned G = gridDim.x * gridDim.y * gridDim.z;
    unsigned sum, cnt, mine, sp = 0u;
    for (;;) {
        sum = 0u; cnt = 0u; mine = 0u;
#pragma unroll
        for (unsigned j = 0; j < 16; ++j) { const unsigned c = xb_ld(&bar[XB_XCNT(j)]); sum += c; cnt += (c > 0u) ? 1u : 0u; mine = (j == x) ? c : mine; }
        if (sum == G) break;
        __builtin_amdgcn_s_sleep(1);
        if ((++sp & 255u) == 0u) { if (xb_ld(&bar[XB_TMO])) break; if (sp > XB_SPIN_CAP) { atomicAdd(&bar[XB_TMO], 1u); break; } }
    }
    nloc = mine > 0u ? mine : 1u; nx = cnt > 0u ? cnt : 1u;
}
__device__ __forceinline__ void xcd_barrier(const XcdBarrier& b) {
    asm volatile("s_waitcnt vmcnt(0)" ::: "memory");
    __syncthreads();
    if (threadIdx.x == 0) {
        unsigned* bar = b.bar;
        __builtin_amdgcn_s_waitcnt(0);
        unsigned nloc = b.st[0], nx = b.st[1];
        if (nloc == 0u) { xcd_barrier_complete(bar, b.x, nloc, nx); b.st[0] = nloc; b.st[1] = nx; }
        const unsigned old = xb_add(&bar[XB_XSUB(b.x)], 1u);
        const unsigned gen = old / nloc;
        if (old + 1u == (gen + 1u) * nloc) {
            __builtin_amdgcn_fence(__ATOMIC_RELEASE, "agent");
            asm volatile("s_waitcnt vmcnt(0)" ::: "memory");
            const unsigned og = xb_add(&bar[XB_TOP], 1u);
            const unsigned tg = og / nx;
            if (og + 1u == (tg + 1u) * nx) xb_add(&bar[XB_TOPGEN], 1u);
            else XB_SPIN(xb_ld(&bar[XB_TOPGEN]) == tg, bar);
            __builtin_amdgcn_fence(__ATOMIC_ACQUIRE, "agent");
            xb_add(&bar[XB_XGEN(b.x)], 1u);
            asm volatile("s_waitcnt vmcnt(0)" ::: "memory");
        } else {
            XB_SPIN(xb_ld(&bar[XB_XGEN(b.x)]) == gen, bar);
            __builtin_amdgcn_fence(__ATOMIC_ACQUIRE, "agent");
            asm volatile("s_waitcnt vmcnt(0)" ::: "memory");
        }
    }
    __syncthreads();
}

__device__ __forceinline__ float wave_sum(float v) {
#pragma unroll
    for (int o = 1; o < 64; o <<= 1) v += __shfl_xor(v, o);
    return v;
}
__device__ __forceinline__ float wave_max(float v) {
#pragma unroll
    for (int o = 1; o < 64; o <<= 1) v = fmaxf(v, __shfl_xor(v, o));
    return v;
}
__device__ __forceinline__ unsigned f2bf(float f) { unsigned u = __builtin_bit_cast(unsigned, f); return (u + 0x7fffu + ((u >> 16) & 1u)) >> 16; }
__device__ __forceinline__ unsigned pk2(float lo, float hi) { return f2bf(lo) | (f2bf(hi) << 16); }
__device__ __forceinline__ float bf2f(bf16_t b) { return __builtin_bit_cast(float, (unsigned)b << 16); }
__device__ __forceinline__ float bflo(unsigned w) { return __builtin_bit_cast(float, w << 16); }
__device__ __forceinline__ float bfhi(unsigned w) { return __builtin_bit_cast(float, w & 0xffff0000u); }
__device__ __forceinline__ float siluf(float x) { return x / (1.0f + expf(-x)); }
__device__ __forceinline__ float sigmf(float x) { return 1.0f / (1.0f + expf(-x)); }
__device__ __forceinline__ float gelu_tanh(float x) { return 0.5f * x * (1.0f + tanhf(0.7978845608028654f * (x + 0.044715f * x * x * x))); }
__device__ __forceinline__ float block_sum(float v, LAS float* red) {
    v = wave_sum(v);
    __syncthreads();
    if ((threadIdx.x & 63) == 0) red[threadIdx.x >> 6] = v;
    __syncthreads();
    float s = 0.f;
#pragma unroll
    for (int i = 0; i < 8; ++i) s += red[i];
    return s;
}

struct Params { const float* in[33]; float* out; unsigned char* ws; int ph_lo, ph_hi; };
enum { I_X = 0, I_C, I_CTX, I_CCTX, I_ADAW, I_ADAB, I_NMIX, I_NFFN, I_ONORM, I_WOUT, I_WAB, I_QN, I_KN, I_SINK, I_SCW, I_SCB, I_WCD, I_POOLW, I_POOLS,
       I_LCW, I_LCB, I_LWA, I_LBA, I_LWX, I_LBX, I_LAM, I_RGW, I_RGB, I_REW, I_REB, I_W1, I_W3, I_W2 };


#define KAS __attribute__((address_space(4)))
__device__ __forceinline__ const float* pin(int i) { const KAS Params* q = (const KAS Params*)__builtin_amdgcn_kernarg_segment_ptr(); asm volatile("" : "+s"(q)); return q->in[i]; }
__device__ __forceinline__ float* pout() { const KAS Params* q = (const KAS Params*)__builtin_amdgcn_kernarg_segment_ptr(); asm volatile("" : "+s"(q)); return q->out; }

__device__ __forceinline__ void transpose_item(const float* W, int N, int K, bf16_t* WT, int kb, int n0, int row_off, const float* gain, LAS float* scr, int lane) {
    const int k0 = 64 * kb;
#pragma unroll 8
    for (int i = 0; i < 32; ++i) { const int kk = 2 * i + (lane >> 5); float w = W[(size_t)(k0 + kk) * N + n0 + (lane & 31)]; if (gain) w *= gain[k0 + kk]; scr[kk * 33 + (lane & 31)] = w; }
    asm volatile("s_waitcnt lgkmcnt(0)" ::: "memory");
    const int c = lane & 7;
#pragma unroll
    for (int j = 0; j < 4; ++j) { const int n = (lane >> 3) + 8 * j; const LAS float* s = scr + (8 * c) * 33 + n;
        u32x4 o; o.x = pk2(s[0 * 33], s[1 * 33]); o.y = pk2(s[2 * 33], s[3 * 33]); o.z = pk2(s[4 * 33], s[5 * 33]); o.w = pk2(s[6 * 33], s[7 * 33]);
        *(u32x4*)(WT + (size_t)(row_off + n) * K + k0 + 8 * c) = o; }
    asm volatile("s_waitcnt lgkmcnt(0)" ::: "memory");
}
__device__ __forceinline__ void convert_experts(const float* w1, const float* w3, const float* w2, bf16_t* W13T, bf16_t* W2T, LAS float* scr, int gw, int NGW, int lane) {
    constexpr int I13 = NEXP * 16 * 16, I2 = NEXP * 8 * 32;
    for (int it = gw; it < 2 * I13 + I2; it += NGW) {
        if (it < 2 * I13) { const int which = it / I13, r = it % I13, e = r / 256, q = r % 256, kb = q / 16, nb = q % 16, n0 = nb * 32;
            const float* W = (which ? w3 : w1) + (size_t)e * DM * DEXP;
            transpose_item(W, DEXP, DM, W13T + (size_t)e * DM * DM, kb, n0, (n0 / 128) * 256 + which * 128 + (n0 % 128), nullptr, scr, lane); }
        else { const int r = it - 2 * I13, e = r / 256, q = r % 256, kb = q / 32, nb = q % 32;
            transpose_item(w2 + (size_t)e * DEXP * DM, DM, DEXP, W2T + (size_t)e * DM * DEXP, kb, nb * 32, nb * 32, nullptr, scr, lane); }
    }
}
__device__ __forceinline__ void router_row(const f32x4 (&tk)[4], int lane, const float* gw, const float* gb, const float* ew, const float* eb, int& ea, int& eb2, float& w0, float& w1) {
    float lg[36];
#pragma unroll
    for (int i = 0; i < 36; ++i) lg[i] = 0.f;
#pragma unroll
    for (int j = 0; j < 4; ++j)
#pragma unroll
        for (int q = 0; q < 4; ++q) {
            const int k = 4 * lane + 256 * j + q; const float t = tk[j][q];
            const f32x4 g4 = *(const f32x4*)(gw + k * 4);
#pragma unroll
            for (int i = 0; i < 4; ++i) lg[i] += t * g4[i];
#pragma unroll
            for (int c8 = 0; c8 < 8; ++c8) { const f32x4 e4 = *(const f32x4*)(ew + k * 32 + c8 * 4);
#pragma unroll
                for (int i = 0; i < 4; ++i) lg[4 + c8 * 4 + i] += t * e4[i]; }
        }
#pragma unroll
    for (int i = 0; i < 36; ++i) lg[i] = wave_sum(lg[i]) + (i < 4 ? gb[i] : eb[i - 4]);
    int gi = 0; float gm = lg[0];
#pragma unroll
    for (int j = 1; j < 4; ++j) if (lg[j] > gm) { gm = lg[j]; gi = j; }
    float gs = 0.f;
#pragma unroll
    for (int j = 0; j < 4; ++j) gs += expf(lg[j] - gm);
    const float p_sel = 1.0f / gs;
    float el[8];
#pragma unroll
    for (int j = 0; j < 8; ++j) el[j] = gi == 0 ? lg[4 + j] : gi == 1 ? lg[12 + j] : gi == 2 ? lg[20 + j] : lg[28 + j];
    int i0 = 0; float m0 = el[0];
#pragma unroll
    for (int j = 1; j < 8; ++j) if (el[j] > m0) { m0 = el[j]; i0 = j; }
    int i1 = 0; float m1 = -INFINITY;
#pragma unroll
    for (int j = 0; j < 8; ++j) if (j != i0 && el[j] > m1) { m1 = el[j]; i1 = j; }
    const float e1 = expf(m1 - m0);
    w0 = p_sel / (1.0f + e1); w1 = p_sel * e1 / (1.0f + e1); ea = gi * 8 + i0; eb2 = gi * 8 + i1;
}
__device__ __forceinline__ void modulate_row(const f32x4 (&v)[4], int lane, const float* g, const float* sh, const float* sc, bf16_t* orow, f32x4 (&o)[4]) {
    float ss = 0.f;
#pragma unroll
    for (int j = 0; j < 4; ++j) ss += (v[j].x * v[j].x + v[j].y * v[j].y) + (v[j].z * v[j].z + v[j].w * v[j].w);
    const float rs = rsqrtf(wave_sum(ss) * (1.0f / DM) + EPSF);
#pragma unroll
    for (int j = 0; j < 4; ++j) { const int c = 4 * lane + 256 * j;
        const f32x4 gg = *(const f32x4*)(g + c), s1 = *(const f32x4*)(sc + c), s0 = *(const f32x4*)(sh + c);
        o[j] = v[j] * rs * gg * (1.0f + s1) + s0;
        u32x2 w; w.x = pk2(o[j].x, o[j].y); w.y = pk2(o[j].z, o[j].w);
        *(u32x2*)(orow + c) = w; }
}
__device__ __forceinline__ void moe_table(const unsigned* counts, LAS int* tab) {
    if (threadIdx.x == 0) {
        int mt = 0;
        for (int e = 0; e < NEXP; ++e) { tab[1 + e] = mt * 256; const int n = ((int)counts[e] + 255) >> 8; for (int i = 0; i < n && mt < MAX_MT; ++i) tab[64 + mt++] = e; }
        tab[0] = mt;
    }
    __syncthreads();
}


__device__ __forceinline__ void attn_conv_phase(LAS unsigned char* lds, const bf16_t* zb, const bf16_t* VtL, const bf16_t* VtC, bf16_t* ybuf, int bx, int G, int tid, int lane, int wave) {
    constexpr int K_OFF = 0, VT_OFF = 73728, VT_ROW = 1152, OUT_ROW = 1040, SSQ_OFF = 64 * OUT_ROW;
    constexpr float LOG2E = 1.44269504088896f, C2 = 0.125f * LOG2E;
    const int r = lane & 31, hh = lane >> 5, g = wave >> 1, th = wave & 1;
    for (int u = bx; u < 272; u += G) {
        const bool isctx = u >= 256;
        const int b = isctx ? ((u - 256) >> 2) : (u >> 6);
        const int q0 = isctx ? ((u - 256) & 3) * 64 : (u & 63) * 64;
        const int rowbase = isctx ? NT + b * CTXL : b * SEQL, ctxbase = NT + b * CTXL;
        unsigned tmask = 0x1E0u;
        if (!isctx) {
#pragma unroll
            for (int T = 0; T < 5; ++T) { const int k0 = q0 - 128 + 64 * T; if (k0 >= 0 && k0 < SEQL) tmask |= 1u << T; }
        }
        f32x16 Ok[2][2]; float ssq = 0.f;
#pragma unroll
        for (int kvh = 0; kvh < 2; ++kvh) {
            __syncthreads();
            {
                const int rw = tid >> 3, c = tid & 7, sw = ((c ^ ((rw >> 1) & 7)) << 4);
                u32x4 kreg[9], vreg[9];
#pragma unroll
                for (int T = 0; T < 9; ++T) if ((tmask >> T) & 1u) {
                    const int krow = T < 5 ? rowbase + q0 - 128 + 64 * T + rw : ctxbase + (T - 5) * 64 + rw;
                    kreg[T] = *(const u32x4*)(zb + (size_t)krow * IN_AB + kvh * 64 + c * 8);
                    const bf16_t* vsrc = T < 5 ? VtL + ((size_t)((b * 2 + kvh) * 64 + rw) * SEQL + (q0 - 128 + 64 * T) + c * 8)
                                               : VtC + ((size_t)((b * 2 + kvh) * 64 + rw) * CTXL + (T - 5) * 64 + c * 8);
                    vreg[T] = *(const u32x4*)vsrc; }
#pragma unroll
                for (int T = 0; T < 9; ++T) if ((tmask >> T) & 1u) {
                    *(LAS u32x4*)(lds + K_OFF + T * 8192 + rw * 128 + sw) = kreg[T];
                    *(LAS u32x4*)(lds + VT_OFF + rw * VT_ROW + T * 128 + sw) = vreg[T]; }
            }
            __syncthreads();
            const int head = kvh * 4 + g;
            const size_t qrow = (size_t)(rowbase + q0 + 32 * th + r);
            bf16x8 Qf[4];
#pragma unroll
            for (int s = 0; s < 4; ++s) Qf[s] = *(const bf16x8*)(zb + qrow * IN_AB + 256 + head * 64 + 16 * s + 8 * hh);
            float m = pin(I_SINK)[head] * LOG2E, l = hh == 0 ? 1.f : 0.f;
            f32x16 O0, O1;
#pragma unroll
            for (int i = 0; i < 16; ++i) { O0[i] = 0.f; O1[i] = 0.f; }
            for (int T = 0; T < 9; ++T) {
                if (!((tmask >> T) & 1u)) continue;
                f32x16 S0, S1;
#pragma unroll
                for (int i = 0; i < 16; ++i) { S0[i] = 0.f; S1[i] = 0.f; }
#pragma unroll
                for (int s = 0; s < 4; ++s) {
                    const int key0 = r, key1 = 32 + r;
                    const bf16x8 k0 = *(const LAS bf16x8*)(lds + K_OFF + T * 8192 + key0 * 128 + (((2 * s + hh) ^ ((key0 >> 1) & 7)) << 4));
                    const bf16x8 k1 = *(const LAS bf16x8*)(lds + K_OFF + T * 8192 + key1 * 128 + (((2 * s + hh) ^ ((key1 >> 1) & 7)) << 4));
                    S0 = MFMA32(k0, Qf[s], S0); S1 = MFMA32(k1, Qf[s], S1);
                }
                if (!isctx && (T == 0 || T == 4)) {
                    const int lim = 32 * th + r;
#pragma unroll
                    for (int i = 0; i < 16; ++i) { const int key = (i & 3) + 8 * (i >> 2) + 4 * hh;
                        const bool ok0 = T == 0 ? key >= lim : key <= lim, ok1 = T == 0 ? key + 32 >= lim : key + 32 <= lim;
                        S0[i] = ok0 ? S0[i] : -INFINITY; S1[i] = ok1 ? S1[i] : -INFINITY; }
                }
                float mx = fmaxf(S0[0], S1[0]);
#pragma unroll
                for (int i = 1; i < 16; ++i) mx = fmaxf(mx, fmaxf(S0[i], S1[i]));
                mx = fmaxf(mx, __shfl_xor(mx, 32));
                const float mn = fmaxf(m, mx * C2), alpha = __builtin_amdgcn_exp2f(m - mn); m = mn;
                float ls = 0.f;
#pragma unroll
                for (int i = 0; i < 16; ++i) { S0[i] = __builtin_amdgcn_exp2f(__builtin_fmaf(S0[i], C2, -m)); S1[i] = __builtin_amdgcn_exp2f(__builtin_fmaf(S1[i], C2, -m)); ls += S0[i] + S1[i]; }
                l = l * alpha + ls;
#pragma unroll
                for (int i = 0; i < 16; ++i) { O0[i] *= alpha; O1[i] *= alpha; }
#pragma unroll
                for (int ks = 0; ks < 4; ++ks) {
                    u32x4 pw;
                    if (ks < 2) { pw.x = pkbf(S0[8 * ks + 0], S0[8 * ks + 1]); pw.y = pkbf(S0[8 * ks + 2], S0[8 * ks + 3]); pw.z = pkbf(S0[8 * ks + 4], S0[8 * ks + 5]); pw.w = pkbf(S0[8 * ks + 6], S0[8 * ks + 7]); }
                    else { const int o = 8 * (ks - 2); pw.x = pkbf(S1[o + 0], S1[o + 1]); pw.y = pkbf(S1[o + 2], S1[o + 3]); pw.z = pkbf(S1[o + 4], S1[o + 5]); pw.w = pkbf(S1[o + 6], S1[o + 7]); }
                    const bf16x8 pf = __builtin_bit_cast(bf16x8, pw);
                    const int d0 = r, d1 = 32 + r;
                    const bf16x8 v0 = *(const LAS bf16x8*)(lds + VT_OFF + d0 * VT_ROW + T * 128 + (((2 * ks + hh) ^ ((d0 >> 1) & 7)) << 4));
                    const bf16x8 v1 = *(const LAS bf16x8*)(lds + VT_OFF + d1 * VT_ROW + T * 128 + (((2 * ks + hh) ^ ((d1 >> 1) & 7)) << 4));
                    O0 = MFMA32(v0, pf, O0); O1 = MFMA32(v1, pf, O1);
                }
            }
            const float inv = 1.0f / (l + __shfl_xor(l, 32));
#pragma unroll
            for (int i = 0; i < 16; ++i) { O0[i] *= inv; O1[i] *= inv; ssq += O0[i] * O0[i] + O1[i] * O1[i]; }
            Ok[kvh][0] = O0; Ok[kvh][1] = O1;
        }
        __syncthreads();
#pragma unroll
        for (int kvh = 0; kvh < 2; ++kvh)
#pragma unroll
            for (int dt = 0; dt < 2; ++dt)
#pragma unroll
                for (int i = 0; i < 4; ++i) { const f32x16& O = Ok[kvh][dt];
                    u32x2 w; w.x = pkbf(O[4 * i], O[4 * i + 1]); w.y = pkbf(O[4 * i + 2], O[4 * i + 3]);
                    *(LAS u32x2*)(lds + (32 * th + r) * OUT_ROW + ((kvh * 4 + g) * 64 + 32 * dt + 8 * i + 4 * hh) * 2) = w; }
        ssq += __shfl_xor(ssq, 32);
        if (hh == 0) ((LAS float*)(lds + SSQ_OFF))[wave * 32 + r] = ssq;
        __syncthreads();
#pragma unroll
        for (int i = 0; i < 8; ++i) {
            const int tok = 8 * wave + i, t2 = tok >> 5, rr = tok & 31;
            const LAS float* sq = (const LAS float*)(lds + SSQ_OFF);
            const float ss = (sq[(0 + t2) * 32 + rr] + sq[(2 + t2) * 32 + rr]) + (sq[(4 + t2) * 32 + rr] + sq[(6 + t2) * 32 + rr]);
            const float rs = rsqrtf(ss * (1.0f / 512.0f) + EPSF);
            const u32x4 v = *(const LAS u32x4*)(lds + tok * OUT_ROW + lane * 16);
            u32x4 o; o.x = pkbf(bflo(v.x) * rs, bfhi(v.x) * rs); o.y = pkbf(bflo(v.y) * rs, bfhi(v.y) * rs); o.z = pkbf(bflo(v.z) * rs, bfhi(v.z) * rs); o.w = pkbf(bflo(v.w) * rs, bfhi(v.w) * rs);
            *(u32x4*)(ybuf + (size_t)(rowbase + q0 + tok) * DM + 8 * lane) = o;
        }
        {
            const int c0 = 8 * lane, pos0 = q0 + 8 * wave, len = isctx ? CTXL : SEQL;
            float wk[3][8], bk[8];
#pragma unroll
            for (int k = 0; k < 3; ++k) { const f32x4 a = *(const f32x4*)(pin(I_SCW) + k * 512 + c0), bq = *(const f32x4*)(pin(I_SCW) + k * 512 + c0 + 4);
#pragma unroll
                for (int j = 0; j < 4; ++j) { wk[k][j] = a[j]; wk[k][4 + j] = bq[j]; } }
            { const f32x4 a = *(const f32x4*)(pin(I_SCB) + c0), bq = *(const f32x4*)(pin(I_SCB) + c0 + 4);
#pragma unroll
              for (int j = 0; j < 4; ++j) { bk[j] = a[j]; bk[4 + j] = bq[j]; } }
            float pr[10][8];
#pragma unroll
            for (int q = 0; q < 10; ++q) { const int pos = pos0 + q - 1;
                if (pos >= 0 && pos < len) { const bf16_t* zr = zb + (size_t)(rowbase + pos) * IN_AB; const u32x4 a = *(const u32x4*)(zr + 1280 + c0), bq = *(const u32x4*)(zr + 1792 + c0);
                    pr[q][0] = bflo(a.x) * bflo(bq.x); pr[q][1] = bfhi(a.x) * bfhi(bq.x); pr[q][2] = bflo(a.y) * bflo(bq.y); pr[q][3] = bfhi(a.y) * bfhi(bq.y);
                    pr[q][4] = bflo(a.z) * bflo(bq.z); pr[q][5] = bfhi(a.z) * bfhi(bq.z); pr[q][6] = bflo(a.w) * bflo(bq.w); pr[q][7] = bfhi(a.w) * bfhi(bq.w); }
                else {
#pragma unroll
                    for (int j = 0; j < 8; ++j) pr[q][j] = 0.f; } }
#pragma unroll
            for (int i = 0; i < 8; ++i) {
                const size_t row = (size_t)(rowbase + pos0 + i);
                const u32x4 gbv = *(const u32x4*)(zb + row * IN_AB + 768 + c0);
                const float gbf[8] = {bflo(gbv.x), bfhi(gbv.x), bflo(gbv.y), bfhi(gbv.y), bflo(gbv.z), bfhi(gbv.z), bflo(gbv.w), bfhi(gbv.w)};
                float cv[8], ss = 0.f;
#pragma unroll
                for (int j = 0; j < 8; ++j) { cv[j] = gbf[j] * (bk[j] + wk[0][j] * pr[i][j] + wk[1][j] * pr[i + 1][j] + wk[2][j] * pr[i + 2][j]); ss += cv[j] * cv[j]; }
                const float rs = rsqrtf(wave_sum(ss) * (1.0f / 512.0f) + EPSF);
                u32x4 o; o.x = pkbf(cv[0] * rs, cv[1] * rs); o.y = pkbf(cv[2] * rs, cv[3] * rs); o.z = pkbf(cv[4] * rs, cv[5] * rs); o.w = pkbf(cv[6] * rs, cv[7] * rs);
                *(u32x4*)(ybuf + row * DM + 512 + c0) = o;
            }
        }
    }
}


constexpr int XL_ROW = 144, XL_WAVE = 64 * XL_ROW;
constexpr int LRU_OUT_ROW = 1040;
__device__ __forceinline__ float sigm_fast(float x) { return __builtin_amdgcn_rcpf(1.0f + __builtin_amdgcn_exp2f(-1.44269504f * x)); }
struct Aff { float A, B; };
__device__ __forceinline__ Aff aff_then(Aff f, Aff g) { Aff o; o.A = f.A * g.A; o.B = g.A * f.B + g.B; return o; }

__device__ __forceinline__ void lru_conv_tile(const bf16_t* z1, int row0, int pos0, int len, int h, int lane, LAS unsigned char* XLw) {
    const int ch = 64 * h + lane;
    const float w0 = pin(I_LCW)[ch], w1 = pin(I_LCW)[512 + ch], w2 = pin(I_LCW)[1024 + ch], w3 = pin(I_LCW)[1536 + ch], cb = pin(I_LCB)[ch];
    const bf16_t* src = z1 + (size_t)(row0 - pos0) * IN_CD + ch;
    float um2 = (pos0 - 2 >= 0) ? bf2f(src[(size_t)(pos0 - 2) * IN_CD]) : 0.f;
    float um1 = (pos0 - 1 >= 0) ? bf2f(src[(size_t)(pos0 - 1) * IN_CD]) : 0.f;
    float u0 = bf2f(src[(size_t)pos0 * IN_CD]);
#pragma unroll 8
    for (int t = 0; t < 64; ++t) {
        const int pn = pos0 + t + 1;
        const float up1 = pn < len ? bf2f(src[(size_t)pn * IN_CD]) : 0.f;
        *(LAS bf16_t*)(XLw + t * XL_ROW + lane * 2) = (bf16_t)f2bf(cb + w0 * um2 + w1 * um1 + w2 * u0 + w3 * up1);
        um2 = um1; um1 = u0; u0 = up1;
    }
    asm volatile("s_waitcnt lgkmcnt(0)" ::: "memory");
}
__device__ __forceinline__ void lru_gates(const LAS unsigned char* XLw, const bf16_t* WaxT, int d, int h, int ct, int rt, int r, int hh, f32x16& a, f32x16& b) {
    const bf16_t* wa = WaxT + ((size_t)((d * 2 + 0) * 8 + h) * 64 + 32 * ct + r) * 64 + 8 * hh;
    const bf16_t* wx = WaxT + ((size_t)((d * 2 + 1) * 8 + h) * 64 + 32 * ct + r) * 64 + 8 * hh;
    f32x16 ra, rx, xc;
#pragma unroll
    for (int i = 0; i < 16; ++i) { ra[i] = 0.f; rx[i] = 0.f; xc[i] = 0.f; }
#pragma unroll
    for (int s = 0; s < 4; ++s) {
        const bf16x8 af = *(const LAS bf16x8*)(XLw + (32 * rt + r) * XL_ROW + (16 * s + 8 * hh) * 2);
        const bf16x8 fa = *(const bf16x8*)(wa + 16 * s), fx = *(const bf16x8*)(wx + 16 * s);
        ra = MFMA32(af, fa, ra); rx = MFMA32(af, fx, rx);
        if ((s >> 1) == ct) {
            const int k0 = 16 * s + 8 * hh, c = 32 * ct + r; u32x4 iw;
            iw.x = (k0 + 0 == c ? 0x3F80u : 0u) | (k0 + 1 == c ? 0x3F800000u : 0u); iw.y = (k0 + 2 == c ? 0x3F80u : 0u) | (k0 + 3 == c ? 0x3F800000u : 0u);
            iw.z = (k0 + 4 == c ? 0x3F80u : 0u) | (k0 + 5 == c ? 0x3F800000u : 0u); iw.w = (k0 + 6 == c ? 0x3F80u : 0u) | (k0 + 7 == c ? 0x3F800000u : 0u);
            xc = MFMA32(af, __builtin_bit_cast(bf16x8, iw), xc);
        }
    }
    const int ch = 64 * h + 32 * ct + r;
    const float bav = pin(I_LBA)[d * 512 + ch], bxv = pin(I_LBX)[d * 512 + ch], nl = -pin(I_LAM)[d * 512 + ch];
    const float sp8 = 8.0f * 1.44269504f * (nl > 20.f ? nl : log1pf(expf(nl)));
#pragma unroll
    for (int i = 0; i < 16; ++i) {
        const float rr = sigm_fast(ra[i] + bav), gi = sigm_fast(rx[i] + bxv);
        const float la2 = -sp8 * rr, av = __builtin_amdgcn_exp2f(la2), y = 1.3862943611f * la2;
        const float om = y > -0.1f ? -y * (1.0f + y * (0.5f + y * (0.16666667f + y * (0.041666668f + y * 0.0083333333f)))) : 1.0f - av * av;
        a[i] = av; b[i] = __builtin_sqrtf(om) * gi * xc[i];
    }
}
__device__ __forceinline__ void lru_groups(const f32x16& a, const f32x16& b, int d, Aff (&own)[4], Aff (&par)[4]) {
#pragma unroll
    for (int g = 0; g < 4; ++g) {
        const float a0 = a[4 * g], a1 = a[4 * g + 1], a2 = a[4 * g + 2], a3 = a[4 * g + 3];
        const float b0 = b[4 * g], b1 = b[4 * g + 1], b2 = b[4 * g + 2], b3 = b[4 * g + 3];
        Aff o; o.A = (a0 * a1) * (a2 * a3);
        o.B = d == 0 ? ((b0 * a1 + b1) * a2 + b2) * a3 + b3 : ((b3 * a2 + b2) * a1 + b1) * a0 + b0;
        own[g] = o; par[g].A = __shfl_xor(o.A, 32); par[g].B = __shfl_xor(o.B, 32);
    }
}
__device__ __forceinline__ void rows_norm_store(const LAS unsigned char* tile, bf16_t* ybuf, int row0, int col_off, int wave, int lane, const bf16_t* gate, int gate_ld) {
#pragma unroll
    for (int i = 0; i < 8; ++i) {
        const int tok = 8 * wave + i;
        const u32x4 v = *(const LAS u32x4*)(tile + tok * LRU_OUT_ROW + lane * 16);
        float f[8] = {bflo(v.x), bfhi(v.x), bflo(v.y), bfhi(v.y), bflo(v.z), bfhi(v.z), bflo(v.w), bfhi(v.w)};
        if (gate) {
            const u32x4 gv = *(const u32x4*)(gate + (size_t)(row0 + tok) * gate_ld + 8 * lane);
            const float ug[8] = {bflo(gv.x), bfhi(gv.x), bflo(gv.y), bfhi(gv.y), bflo(gv.z), bfhi(gv.z), bflo(gv.w), bfhi(gv.w)};
#pragma unroll
            for (int j = 0; j < 8; ++j) { const float uu = 0.7978845608f * (ug[j] + 0.044715f * ug[j] * ug[j] * ug[j]); f[j] *= ug[j] * sigm_fast(2.0f * uu); }
        }
        float ss = 0.f;
#pragma unroll
        for (int j = 0; j < 8; ++j) ss += f[j] * f[j];
        const float rs = rsqrtf(wave_sum(ss) * (1.0f / 512.0f) + EPSF);
        u32x4 o; o.x = pkbf(f[0] * rs, f[1] * rs); o.y = pkbf(f[2] * rs, f[3] * rs); o.z = pkbf(f[4] * rs, f[5] * rs); o.w = pkbf(f[6] * rs, f[7] * rs);
        *(u32x4*)(ybuf + (size_t)(row0 + tok) * DM + col_off + 8 * lane) = o;
    }
}
__device__ __forceinline__ void chunk_geom(int cidx, int& b, int& j, int& row0, int& len) {
    if (cidx < 256) { b = cidx >> 6; j = cidx & 63; row0 = b * SEQL + j * 64; len = SEQL; } else { const int cc = cidx - 256; b = cc >> 2; j = cc & 3; row0 = NT + b * CTXL + j * 64; len = CTXL; }
}
__device__ __forceinline__ void lru_phase_a(LAS unsigned char* lds, const bf16_t* z1, const bf16_t* WaxT, const bf16_t* PWT, f32x2* summ, bf16_t* ybuf, int bx, int G, int tid, int lane, int wave) {
    const int h = wave;
    LAS unsigned char* XLw = lds + wave * XL_WAVE;
    for (int cidx = bx; cidx < 272; cidx += G) {
        asm volatile("" : "+v"(lane), "+v"(tid));
        const int r = lane & 31, hh = lane >> 5;
        int b, j, row0, len; chunk_geom(cidx, b, j, row0, len);
        __syncthreads();
        lru_conv_tile(z1, row0, j * 64, len, h, lane, XLw);
#pragma unroll
        for (int d = 0; d < 2; ++d)
#pragma unroll
            for (int ct = 0; ct < 2; ++ct) {
                Aff tot; tot.A = 1.f; tot.B = 0.f;
#pragma unroll
                for (int q = 0; q < 2; ++q) {
                    const int rt = d == 0 ? q : 1 - q;
                    int rq = r, hq = hh; asm volatile("" : "+v"(rq), "+v"(hq));
                    f32x16 a, bb; lru_gates(XLw, WaxT, d, h, ct, rt, rq, hq, a, bb);
                    Aff own[4], par[4]; lru_groups(a, bb, d, own, par);
#pragma unroll
                    for (int gq = 0; gq < 4; ++gq) {
                        const int g = d == 0 ? gq : 3 - gq;
                        const Aff c0 = hh == 0 ? own[g] : par[g], c1 = hh == 0 ? par[g] : own[g];
                        tot = d == 0 ? aff_then(aff_then(tot, c0), c1) : aff_then(aff_then(tot, c1), c0);
                    }
                }
                if (hh == 0) summ[((size_t)cidx * 2 + d) * 512 + 64 * h + 32 * ct + r] = (f32x2){tot.A, tot.B};
            }
        if (cidx >= 256) continue;
        __syncthreads();
        LAS unsigned char* Dt = lds; LAS unsigned char* Ot = lds + 64 * LRU_OUT_ROW;
        {
            const int c = tid, hw = 1 << (c >> 7), pos0 = j * 64;
            const bf16_t* src = z1 + (size_t)(row0 - pos0) * IN_CD + 1024 + c;
            float S = 0.f;
            for (int q = pos0 - hw; q < pos0 + hw; ++q) if (q >= 0 && q < SEQL) S += bf2f(src[(size_t)q * IN_CD]);
#pragma unroll 4
            for (int t = 0; t < 64; ++t) {
                const int pos = pos0 + t, lo = max(pos - hw, 0), hi = min(pos + hw, SEQL);
                const float uc = bf2f(src[(size_t)pos * IN_CD]);
                *(LAS bf16_t*)(Dt + t * LRU_OUT_ROW + c * 2) = (bf16_t)f2bf(S / (float)(hi - lo) - uc);
                const float add = pos + hw < SEQL ? bf2f(src[(size_t)(pos + hw) * IN_CD]) : 0.f, sub = pos - hw >= 0 ? bf2f(src[(size_t)(pos - hw) * IN_CD]) : 0.f;
                S += add - sub;
            }
        }
        __syncthreads();
        {
            const int g = wave >> 1, nh = wave & 1;
#pragma unroll
            for (int rt = 0; rt < 2; ++rt) {
                f32x16 y0, y1;
#pragma unroll
                for (int i = 0; i < 16; ++i) { y0[i] = 0.f; y1[i] = 0.f; }
#pragma unroll
                for (int s = 0; s < 8; ++s) {
                    const bf16x8 df = *(const LAS bf16x8*)(Dt + (32 * rt + r) * LRU_OUT_ROW + (128 * g + 16 * s + 8 * hh) * 2);
                    const bf16x8 p0 = *(const bf16x8*)(PWT + ((size_t)(g * 128 + 64 * nh + r)) * 128 + 16 * s + 8 * hh);
                    const bf16x8 p1 = *(const bf16x8*)(PWT + ((size_t)(g * 128 + 64 * nh + 32 + r)) * 128 + 16 * s + 8 * hh);
                    y0 = MFMA32(df, p0, y0); y1 = MFMA32(df, p1, y1);
                }
                const int col0 = 128 * g + 64 * nh + r; const float sc0 = pin(I_POOLS)[col0], sc1 = pin(I_POOLS)[col0 + 32];
#pragma unroll
                for (int i = 0; i < 16; ++i) { const int tok = 32 * rt + (i & 3) + 8 * (i >> 2) + 4 * hh;
                    *(LAS bf16_t*)(Ot + tok * LRU_OUT_ROW + col0 * 2) = (bf16_t)f2bf(y0[i] * sc0);
                    *(LAS bf16_t*)(Ot + tok * LRU_OUT_ROW + (col0 + 32) * 2) = (bf16_t)f2bf(y1[i] * sc1); }
            }
        }
        __syncthreads();
        rows_norm_store(Ot, ybuf, row0, 0, wave, lane, nullptr, 0);
    }
}
__device__ __forceinline__ void lru_phase_b(LAS unsigned char* lds, const bf16_t* z1, const bf16_t* WaxT, const f32x2* summ, bf16_t* ybuf, int bx, int G, int tid, int lane, int wave) {
    const int h = wave;
    LAS unsigned char* XLw = lds + wave * XL_WAVE;
    for (int cidx = bx; cidx < 256; cidx += G) {
        asm volatile("" : "+v"(lane));
        const int r = lane & 31, hh = lane >> 5;
        int b, j, row0, len; chunk_geom(cidx, b, j, row0, len);
        __syncthreads();
        lru_conv_tile(z1, row0, j * 64, len, h, lane, XLw);
        LAS unsigned char* Ot = lds + 8 * XL_WAVE;
#pragma unroll
        for (int ct = 0; ct < 2; ++ct) {
            f32x16 hs[2];
#pragma unroll
            for (int rt = 0; rt < 2; ++rt)
#pragma unroll
                for (int i = 0; i < 16; ++i) hs[rt][i] = 0.f;
            const int ch = 64 * h + 32 * ct + r;
#pragma unroll
            for (int d = 0; d < 2; ++d) {
                float hc = 0.f;
                if (d == 0) {
                    for (int k = 0; k < 4; ++k) { const f32x2 s2 = summ[((size_t)(256 + b * 4 + k) * 2 + 0) * 512 + ch]; hc = s2.x * hc + s2.y; }
                    for (int k = 0; k < j; ++k) { const f32x2 s2 = summ[((size_t)(b * 64 + k) * 2 + 0) * 512 + ch]; hc = s2.x * hc + s2.y; }
                } else {
                    for (int k = 3; k >= 0; --k) { const f32x2 s2 = summ[((size_t)(256 + b * 4 + k) * 2 + 1) * 512 + ch]; hc = s2.x * hc + s2.y; }
                    for (int k = 63; k > j; --k) { const f32x2 s2 = summ[((size_t)(b * 64 + k) * 2 + 1) * 512 + ch]; hc = s2.x * hc + s2.y; }
                }
#pragma unroll
                for (int q = 0; q < 2; ++q) {
                    const int rt = d == 0 ? q : 1 - q;
                    __builtin_amdgcn_sched_barrier(0);
                    int rq = r, hq = hh; asm volatile("" : "+v"(rq), "+v"(hq));
                    f32x16 a, bb; lru_gates(XLw, WaxT, d, h, ct, rt, rq, hq, a, bb);
                    Aff own[4], par[4]; lru_groups(a, bb, d, own, par);
#pragma unroll
                    for (int gq = 0; gq < 4; ++gq) {
                        const int g = d == 0 ? gq : 3 - gq;
                        const Aff c0 = hh == 0 ? own[g] : par[g], c1 = hh == 0 ? par[g] : own[g];
                        if (d == 0) {
                            const float hmid = c0.A * hc + c0.B;
                            float x = hh == 0 ? hc : hmid;
#pragma unroll
                            for (int k = 0; k < 4; ++k) { x = a[4 * g + k] * x + bb[4 * g + k]; hs[rt][4 * g + k] += x; }
                            hc = c1.A * hmid + c1.B;
                        } else {
                            const float hmid = c1.A * hc + c1.B;
                            float x = hh == 1 ? hc : hmid;
#pragma unroll
                            for (int k = 3; k >= 0; --k) { x = a[4 * g + k] * x + bb[4 * g + k]; hs[rt][4 * g + k] += x; }
                            hc = c0.A * hmid + c0.B;
                        }
                    }
                }
            }
#pragma unroll
            for (int rt = 0; rt < 2; ++rt)
#pragma unroll
                for (int i = 0; i < 16; ++i) {
                    const int tok = 32 * rt + (i & 3) + 8 * (i >> 2) + 4 * hh;
                    *(LAS bf16_t*)(Ot + tok * LRU_OUT_ROW + ch * 2) = (bf16_t)f2bf(hs[rt][i]);
                }
        }
        __syncthreads();
        rows_norm_store(lds + 8 * XL_WAVE, ybuf, row0, 512, wave, lane, z1 + 512, IN_CD);
    }
}

#define PHASE_PTRS unsigned* ctl = (unsigned*)(ws + WS_CTL); float* mods = (float*)(ws + WS_MODS); \
    int* eidx = (int*)(ws + WS_EIDX); float* ewt = (float*)(ws + WS_EWT); int* tok_slot = (int*)(ws + WS_TOKSLOT); int* slot_tok = (int*)(ws + WS_SLOTTOK); \
    bf16_t* WabT = (bf16_t*)(ws + WS_WAB); bf16_t* WoutT = (bf16_t*)(ws + WS_WOUT); bf16_t* WcdT = (bf16_t*)(ws + WS_WCD); \
    bf16_t* W13T = (bf16_t*)(ws + WS_W13); bf16_t* W2T = (bf16_t*)(ws + WS_W2); \
    bf16_t* hbuf = (bf16_t*)(ws + WS_HBUF); bf16_t* zb = (bf16_t*)(ws + WS_Z); bf16_t* ybuf = (bf16_t*)(ws + WS_YBUF); \
    float* xbuf = (float*)(ws + WS_XBUF); bf16_t* Hb = (bf16_t*)(ws + WS_H); bf16_t* Yb = (bf16_t*)(ws + WS_Y); \
    bf16_t* VtL = (bf16_t*)(ws + WS_S); bf16_t* VtC = (bf16_t*)(ws + WS_S + 4 * MiB); \
    f32x2* summ = (f32x2*)(ws + WS_S); \
    bf16_t* WaxT = (bf16_t*)(ws + WS_LRUW); bf16_t* PWT = WaxT + 131072; \
    (void)mods; (void)eidx; (void)ewt; (void)tok_slot; (void)slot_tok; (void)WabT; (void)WoutT; (void)WcdT; (void)W13T; (void)W2T; (void)hbuf; (void)zb; (void)ybuf; (void)xbuf; (void)Hb; (void)Yb; (void)VtL; (void)VtC; (void)summ; (void)WaxT; (void)PWT; (void)ctl;
__global__ void __launch_bounds__(NTHR, 2) mk_fwd(Params p) {
    extern __shared__ __attribute__((aligned(16))) unsigned char lds_raw[];
    LAS unsigned char* lds = (LAS unsigned char*)lds_raw;
    const int tid0 = threadIdx.x;
    const int wave0 = __builtin_amdgcn_readfirstlane(tid0 >> 6);
    const int G = gridDim.x, bx = blockIdx.x, NGW = G * NWAVES;
#define PHASE_IDS int lane; asm volatile("v_mbcnt_lo_u32_b32 %0, -1, 0\n\tv_mbcnt_hi_u32_b32 %0, -1, %0" : "=v"(lane)); const int wave = wave0; int tid = wave * 64 + lane; const int gw = bx * NWAVES + wave; (void)gw; (void)tid; \
    LAS float* scrw = (LAS float*)(lds + 32768 + wave * 8704); (void)scrw; unsigned char* ws = ws0; asm volatile("" : "+s"(ws)); PHASE_PTRS
    unsigned char* ws0 = p.ws;
    for (int u = tid0; u < (LDS_BYTES - LDSCTL_OFF) / 4; u += NTHR) ((LAS unsigned*)(lds + LDSCTL_OFF))[u] = 0u;
    __syncthreads();
    unsigned* ctl0 = (unsigned*)(ws0 + WS_CTL);
    XcdBarrier bar; bar.bar = ctl0 + CW_BAR; bar.x = 0; bar.st = nullptr;
    if (!MK_PER_PHASE) bar = xcd_barrier_post(ctl0 + CW_BAR, (volatile LAS unsigned*)(lds + LDSCTL_OFF + 32));
    const int lo = p.ph_lo, hi = p.ph_hi;
#define IN(k) (lo <= (k) && (k) < hi)
#define SEAM(k) do { if ((k) + 1 < hi) xcd_barrier(bar); } while (0)

    LAS int* mtab = (LAS int*)(lds + LDS_MOE_OFF);

    if (IN(0)) { PHASE_IDS;
        {
            LAS float* sil = (LAS float*)lds; LAS float* red = (LAS float*)(lds + 20480);
            for (int i = tid; i < 5 * DM; i += NTHR) { const int r = i >> 10, k = i & 1023; sil[i] = siluf(r < 4 ? pin(I_C)[r * DM + k] : pin(I_CCTX)[k]); }
            __syncthreads();
            for (int item = bx; item < 192; item += G) {
                const int l = item / 96, nb = item % 96, n = nb * 64 + lane;
                const float* W = pin(I_ADAW) + (size_t)l * DM * 6144 + (size_t)(wave * 128) * 6144 + n;
                float a[5] = {0.f, 0.f, 0.f, 0.f, 0.f};
#pragma unroll 8
                for (int k = 0; k < 128; ++k) { const float w = W[(size_t)k * 6144];
#pragma unroll
                    for (int r = 0; r < 5; ++r) a[r] += sil[r * DM + wave * 128 + k] * w; }
#pragma unroll
                for (int r = 0; r < 5; ++r) red[(wave * 5 + r) * 64 + lane] = a[r];
                __syncthreads();
                if (tid < 320) { const int r = tid >> 6; float s = 0.f;
#pragma unroll
                    for (int w = 0; w < 8; ++w) s += red[(w * 5 + r) * 64 + lane];
                    mods[((size_t)l * 5 + r) * 6144 + nb * 64 + lane] = s + pin(I_ADAB)[l * 6144 + nb * 64 + lane]; }
                __syncthreads();
            }
        }
        {
            constexpr int I_AB = 16 * 72, I_O = 16 * 32, I_CDn = 16 * 48;
            for (int it = gw; it < I_AB + 2 * I_O + I_CDn; it += NGW) {
                int r = it;
                if (r < I_AB) { transpose_item(pin(I_WAB), IN_AB, DM, WabT, r / 72, (r % 72) * 32, (r % 72) * 32, nullptr, scrw, lane); continue; } r -= I_AB;
                if (r < 2 * I_O) { const int l = r / I_O, q = r % I_O; transpose_item(pin(I_WOUT) + (size_t)l * DM * DM, DM, DM, WoutT + (size_t)l * DM * DM, q / 32, (q % 32) * 32, (q % 32) * 32, pin(I_ONORM) + l * DM, scrw, lane); continue; } r -= 2 * I_O;
                transpose_item(pin(I_WCD), IN_CD, DM, WcdT, r / 48, (r % 48) * 32, (r % 48) * 32, nullptr, scrw, lane);
            }
        }
        convert_experts(pin(I_W1), pin(I_W3), pin(I_W2), W13T, W2T, scrw, gw, NGW, lane);
        for (int i = bx * NTHR + tid; i < 131072; i += G * NTHR) {
            const int ii = i & 63, jj = (i >> 6) & 63, hq = (i >> 12) & 7, gate = (i >> 15) & 1, d = i >> 16 & 1;
            WaxT[i] = (bf16_t)f2bf((gate ? pin(I_LWX) : pin(I_LWA))[(((size_t)(d * 8 + hq) * 64) + ii) * 64 + jj]);
            if (i < 65536) { const int pi = i & 127, pj = (i >> 7) & 127, pg = i >> 14;
                PWT[i] = (bf16_t)f2bf(pin(I_POOLW)[((size_t)pg * 128 + pi) * 128 + pj]); }
        }
        for (int i = bx * NTHR + tid; i < NSLOT; i += G * NTHR) slot_tok[i] = NR;
        if (bx == 0) for (int i = tid; i < DM / 2; i += NTHR) ((unsigned*)(hbuf + (size_t)NR * DM))[i] = 0u;
        SEAM(0);
    }
    if (IN(1)) { PHASE_IDS;
        for (int row = gw; row < NR; row += NGW) {
            const float* src = row < NT ? pin(I_X) + (size_t)row * DM : pin(I_CTX) + (size_t)(row - NT) * DM;
            const int b = row < NT ? (row >> 12) : 4;
            f32x4 v[4], o[4];
#pragma unroll
            for (int j = 0; j < 4; ++j) v[j] = *(const f32x4*)(src + 4 * lane + 256 * j);
            modulate_row(v, lane, pin(I_NMIX), mods + (size_t)b * 6144, mods + (size_t)b * 6144 + DM, hbuf + (size_t)row * DM, o);
        }
        SEAM(1);
    }
    if (IN(2)) { PHASE_IDS;
        pg8::DenseOrder S; S.init(hbuf, WabT, NR, IN_AB, DM, G, bx);
        pg8::EpiBf16 E{zb, IN_AB};
        pg8::gemm_phase<pg8::EpiBf16, pg8::DenseOrder, false>(lds, S, E);
        SEAM(2);
    }
    if (IN(3)) { PHASE_IDS;
        for (int it = gw; it < NR * 12; it += NGW) {
            const int row = it / 12, hs = it % 12;
            if (hs >= 10) {
                const int kvh = hs - 10; const bf16_t v = zb[(size_t)row * IN_AB + 128 + kvh * 64 + lane];
                if (row < NT) { const int b = row >> 12, pos = row & (SEQL - 1), sg = (pos & ~15) | (pos & 3) | ((pos & 4) << 1) | ((pos & 8) >> 1); VtL[((size_t)((b * 2 + kvh) * 64 + lane)) * SEQL + sg] = v; }
                else { const int b = (row - NT) >> 8, pos = (row - NT) & (CTXL - 1), sg = (pos & ~15) | (pos & 3) | ((pos & 4) << 1) | ((pos & 8) >> 1); VtC[((size_t)((b * 2 + kvh) * 64 + lane)) * CTXL + sg] = v; }
                continue;
            }
            const int col = hs < 8 ? 256 + hs * 64 : (hs - 8) * 64;
            const float* gain = hs < 8 ? pin(I_QN) : pin(I_KN);
            bf16_t* pz = zb + (size_t)row * IN_AB + col + lane;
            const float v = bf2f(*pz);
            const float ss = wave_sum(v * v);
            float y = v * rsqrtf(ss * (1.0f / 64.0f) + EPSF) * gain[lane];
            if (row < NT) {
                const int t = row & (SEQL - 1), r = t >> 6, c = t & 63;
                const int a = lane >> 5, half = (lane >> 4) & 1, i = lane & 15;
                const float inv = powf(10000.0f, -(float)i / 16.0f);
                const float ang = (float)(a == 0 ? r : c) * inv;
                const float cs = cosf(ang), sn = sinf(ang);
                const float partner = __shfl_xor(y, 16);
                y = half == 0 ? y * cs - partner * sn : y * cs + partner * sn;
            }
            *pz = (bf16_t)f2bf(y);
        }
        SEAM(3);
    }
    if (IN(4)) { PHASE_IDS; attn_conv_phase(lds, zb, VtL, VtC, ybuf, bx, G, tid, lane, wave); SEAM(4); }
    if (IN(6)) { PHASE_IDS;
        pg8::DenseOrder S; S.init(ybuf, WoutT, NR, DM, DM, G, bx);
        pg8::EpiX E{pin(I_X), pin(I_CTX), mods + 2 * DM, xbuf};
        pg8::gemm_phase<pg8::EpiX, pg8::DenseOrder, false>(lds, S, E);
        SEAM(6);
    }
#define PH_TOKENS(L, NROWS) do { \
        const float* md = mods + (size_t)(L) * 5 * 6144; \
        for (int row = gw; row < (NROWS); row += NGW) { \
            const int b = row < NT ? (row >> 12) : 4; f32x4 v[4], o[4]; \
            _Pragma("unroll") for (int j = 0; j < 4; ++j) v[j] = *(const f32x4*)(xbuf + (size_t)row * DM + 4 * lane + 256 * j); \
            modulate_row(v, lane, pin(I_NFFN) + (L) * DM, md + (size_t)b * 6144 + 3 * DM, md + (size_t)b * 6144 + 4 * DM, hbuf + (size_t)row * DM, o); \
            int ea, eb2; float w0, w1; \
            router_row(o, lane, pin(I_RGW) + (L) * DM * 4, pin(I_RGB) + (L) * 4, pin(I_REW) + (L) * DM * 32, pin(I_REB) + (L) * 32, ea, eb2, w0, w1); \
            if (lane == 0) { eidx[row * 2] = ea; eidx[row * 2 + 1] = eb2; ewt[row * 2] = w0; ewt[row * 2 + 1] = w1; \
                atomicAdd(ctl + CW_CNT + 64 * (L) + ea, 1u); atomicAdd(ctl + CW_CNT + 64 * (L) + eb2, 1u); } \
        } } while (0)
    if (IN(7)) { PHASE_IDS; PH_TOKENS(0, NR); SEAM(7); }
#define PH_FILL(L, NROWS) do { \
        moe_table(ctl + CW_CNT + 64 * (L), mtab); \
        for (int i = bx * NTHR + tid; i < (NROWS) * 2; i += G * NTHR) { const int e = eidx[i]; \
            const int pos = (int)atomicAdd(ctl + CW_CUR + 64 * (L) + e, 1u); const int slot = mtab[1 + e] + pos; slot_tok[slot] = i >> 1; tok_slot[i] = slot; } \
        } while (0)
    if (IN(8)) { PHASE_IDS; PH_FILL(0, NR); SEAM(8); }
#define PH_UP(L) do { \
        moe_table(ctl + CW_CNT + 64 * (L), mtab); \
        pg8::MoeOrder S; S.A = (const char*)hbuf; S.Bt = (const char*)W13T; S.K = DM; S.estride = (size_t)DM * DM * 2; S.nN = 4; S.G = G; S.c = bx; S.n_mt = mtab[0]; S.tile_e = mtab + 64; S.slot_tok = slot_tok; \
        pg8::EpiH E{Hb}; \
        pg8::gemm_phase<pg8::EpiH, pg8::MoeOrder, true>(lds, S, E); } while (0)
    if (IN(9)) { PHASE_IDS; PH_UP(0); SEAM(9); }
#define PH_DOWN(L) do { \
        moe_table(ctl + CW_CNT + 64 * (L), mtab); \
        pg8::MoeOrder S; S.A = (const char*)Hb; S.Bt = (const char*)W2T; S.K = DEXP; S.estride = (size_t)DM * DEXP * 2; S.nN = 4; S.G = G; S.c = bx; S.n_mt = mtab[0]; S.tile_e = mtab + 64; S.slot_tok = nullptr; \
        pg8::EpiBf16 E{Yb, DM}; \
        pg8::gemm_phase<pg8::EpiBf16, pg8::MoeOrder, false>(lds, S, E); } while (0)
    if (IN(10)) { PHASE_IDS; PH_DOWN(0); SEAM(10); }
    if (IN(11)) { PHASE_IDS;
        const float* md1 = mods + (size_t)5 * 6144;
        for (int row = gw; row < NR; row += NGW) {
            const int b = row < NT ? (row >> 12) : 4;
            const int s0 = tok_slot[row * 2], s1 = tok_slot[row * 2 + 1]; const float w0 = ewt[row * 2], w1 = ewt[row * 2 + 1];
            f32x4 v[4], o[4];
#pragma unroll
            for (int j = 0; j < 4; ++j) { const int c = 4 * lane + 256 * j;
                const f32x4 x = *(const f32x4*)(xbuf + (size_t)row * DM + c), gt = *(const f32x4*)(mods + (size_t)b * 6144 + 5 * DM + c);
                const u32x2 y0 = *(const u32x2*)(Yb + (size_t)s0 * DM + c), y1 = *(const u32x2*)(Yb + (size_t)s1 * DM + c);
                f32x4 m; m.x = w0 * bflo(y0.x) + w1 * bflo(y1.x); m.y = w0 * bfhi(y0.x) + w1 * bfhi(y1.x); m.z = w0 * bflo(y0.y) + w1 * bflo(y1.y); m.w = w0 * bfhi(y0.y) + w1 * bfhi(y1.y);
                v[j] = x + gt * m;
                *(f32x4*)(xbuf + (size_t)row * DM + c) = v[j]; }
            modulate_row(v, lane, pin(I_NMIX) + DM, md1 + (size_t)b * 6144, md1 + (size_t)b * 6144 + DM, hbuf + (size_t)row * DM, o);
        }
        convert_experts(pin(I_W1) + (size_t)NEXP * DM * DEXP, pin(I_W3) + (size_t)NEXP * DM * DEXP, pin(I_W2) + (size_t)NEXP * DEXP * DM, W13T, W2T, scrw, gw, NGW, lane);
        for (int i = bx * NTHR + tid; i < NSLOT; i += G * NTHR) slot_tok[i] = NR;
        SEAM(11);
    }
    if (IN(12)) { PHASE_IDS;
        pg8::DenseOrder S; S.init(hbuf, WcdT, NR, IN_CD, DM, G, bx);
        pg8::EpiBf16 E{zb, IN_CD};
        pg8::gemm_phase<pg8::EpiBf16, pg8::DenseOrder, false>(lds, S, E);
        SEAM(12);
    }
    if (IN(13)) { PHASE_IDS; lru_phase_a(lds, zb, WaxT, PWT, summ, ybuf, bx, G, tid, lane, wave); SEAM(13); }
    if (IN(14)) { PHASE_IDS; lru_phase_b(lds, zb, WaxT, summ, ybuf, bx, G, tid, lane, wave); SEAM(14); }
    if (IN(18)) { PHASE_IDS;
        pg8::DenseOrder S; S.init(ybuf, WoutT + (size_t)DM * DM, NT, DM, DM, G, bx);
        pg8::EpiX E{xbuf, xbuf + (size_t)NT * DM, mods + (size_t)5 * 6144 + 2 * DM, xbuf};
        pg8::gemm_phase<pg8::EpiX, pg8::DenseOrder, false>(lds, S, E);
        SEAM(18);
    }
    if (IN(19)) { PHASE_IDS; PH_TOKENS(1, NT); SEAM(19); }
    if (IN(20)) { PHASE_IDS; PH_FILL(1, NT); SEAM(20); }
    if (IN(21)) { PHASE_IDS; PH_UP(1); SEAM(21); }
    if (IN(22)) { PHASE_IDS; PH_DOWN(1); SEAM(22); }
    if (IN(23)) { PHASE_IDS;
        const float* md1 = mods + (size_t)5 * 6144;
        for (int row = gw; row < NT; row += NGW) {
            const int b = row >> 12;
            const int s0 = tok_slot[row * 2], s1 = tok_slot[row * 2 + 1]; const float w0 = ewt[row * 2], w1 = ewt[row * 2 + 1];
#pragma unroll
            for (int j = 0; j < 4; ++j) { const int c = 4 * lane + 256 * j;
                const f32x4 x = *(const f32x4*)(xbuf + (size_t)row * DM + c), gt = *(const f32x4*)(md1 + (size_t)b * 6144 + 5 * DM + c);
                const u32x2 y0 = *(const u32x2*)(Yb + (size_t)s0 * DM + c), y1 = *(const u32x2*)(Yb + (size_t)s1 * DM + c);
                f32x4 m; m.x = w0 * bflo(y0.x) + w1 * bflo(y1.x); m.y = w0 * bfhi(y0.x) + w1 * bfhi(y1.x); m.z = w0 * bflo(y0.y) + w1 * bflo(y1.y); m.w = w0 * bfhi(y0.y) + w1 * bfhi(y1.y);
                *(f32x4*)(pout() + (size_t)row * DM + c) = x + gt * m; }
        }
    }
#undef IN
#undef SEAM
}
constexpr int NPH = 24;

extern "C" void kernel_launch(void* const* d_in, const int* in_sizes, int n_in, void* d_out, int out_size, void* d_ws, size_t ws_size, hipStream_t stream) {
    static int grid = 0;
    if (grid == 0) {
        if (n_in != 33 || ws_size < WS_END) { fprintf(stderr, "kernel_launch: unexpected n_in %d or ws_size %zu (< %zu)\n", n_in, ws_size, (size_t)WS_END); grid = -1; return; }
        int dev = 0, cus = 0, per_cu = 0;
        if (hipGetDevice(&dev) != hipSuccess || hipDeviceGetAttribute(&cus, hipDeviceAttributeMultiprocessorCount, dev) != hipSuccess) { grid = -1; return; }
        if (hipFuncSetAttribute((const void*)mk_fwd, hipFuncAttributeMaxDynamicSharedMemorySize, LDS_BYTES) != hipSuccess) { fprintf(stderr, "kernel_launch: hipFuncSetAttribute failed\n"); grid = -1; return; }
        if (hipOccupancyMaxActiveBlocksPerMultiprocessor(&per_cu, (const void*)mk_fwd, NTHR, LDS_BYTES) != hipSuccess || per_cu < 1)
            fprintf(stderr, "kernel_launch: occupancy query reports %d workgroups per CU\n", per_cu);
        (void)hipGetLastError();
        grid = cus;
    }
    if (grid < 0) return;
    (void)in_sizes; (void)out_size;
    if (hipMemsetAsync((char*)d_ws + WS_CTL, 0, CTL_ZERO_BYTES, stream) != hipSuccess) return;
    Params a{};
    for (int i = 0; i < 33; ++i) a.in[i] = (const float*)d_in[i];
    a.out = (float*)d_out; a.ws = (unsigned char*)d_ws;
#if MK_PER_PHASE
    for (int ph = 0; ph < NPH; ++ph) { a.ph_lo = ph; a.ph_hi = ph + 1; hipLaunchKernelGGL(mk_fwd, dim3(grid), dim3(NTHR), LDS_BYTES, stream, a); }
#else
    a.ph_lo = 0; a.ph_hi = NPH;
    hipLaunchKernelGGL(mk_fwd, dim3(grid), dim3(NTHR), LDS_BYTES, stream, a);
#endif
}
```
